# Optimizing an MI355X kernel written in HIP

```python
import math
import jax
import jax.numpy as jnp
from jax import lax
import numpy as np

D_MODEL = 1024
BATCH = 1
SEQ = 16384
DEPTH = 2

CHUNK = 64
QBLOCK = 128
GROUP_WIDTH = D_MODEL // 2
DK_A = 64
DV_A = 2 * DK_A
N_HEADS_A = GROUP_WIDTH // DV_A
DH_B = 64
N_HEADS_B = GROUP_WIDTH // DH_B
LEFT_CHUNKS = 8
BAND = (LEFT_CHUNKS + 1) * CHUNK
REL_CLIP = 2 * CHUNK
NUM_BUCKETS = 32
MAX_DISTANCE = 128
DV_C = 128
DQK_C = DV_C // 2
N_HEADS_C = GROUP_WIDTH // DV_C
ROPE_BASE = 10000.0
S5_CH = GROUP_WIDTH
S5_GROUP = 16
S5_GROUPS = S5_CH // S5_GROUP
S5_STATE = 64
D_FF = ((8 * D_MODEL // 3 + 255) // 256) * 256
CONV_W = 3
N_EVEN = (DEPTH + 1) // 2
N_ODD = DEPTH // 2
EVEN_IN = 3 * N_HEADS_A * DV_A + 3 * N_HEADS_B * DH_B
ODD_IN = 2 * N_HEADS_C * DQK_C + 2 * N_HEADS_C * DV_C + S5_CH
EPS = 1e-6
NEG_INF = -1e30

kernel_name = 'hybrid_diffattn_band_retention_s5_trunk'


def rmsnorm(x, g=None):
    xf = x.astype(jnp.float32)
    y = xf * lax.rsqrt(jnp.mean(xf * xf, axis=-1, keepdims=True) + EPS)
    if g is not None:
        y = y * g.astype(jnp.float32)
    return y


def modulated_rmsnorm(x, g, shift, scale):
    y = rmsnorm(x, g) * (1.0 + scale.astype(jnp.float32)[:, None, :]) + shift.astype(jnp.float32)[:, None, :]
    return y.astype(x.dtype)


def t5_bucket(rel):
    nb = NUM_BUCKETS // 2
    max_exact = nb // 2
    bucket = jnp.where(rel > 0, nb, 0)
    n = jnp.abs(rel)
    nf = jnp.maximum(n, 1).astype(jnp.float32)
    large = max_exact + (jnp.log(nf / max_exact) / math.log(MAX_DISTANCE / max_exact) * (nb - max_exact)).astype(jnp.int32)
    large = jnp.minimum(large, nb - 1)
    return bucket + jnp.where(n < max_exact, n, large)


def diff_attention(q, k, v, t5_table, lam, lam_init, subln_g):
    B_, L = q.shape[0], q.shape[1]
    nqb = L // QBLOCK
    q = q.astype(jnp.float32) * (DK_A ** -0.5)
    k = k.astype(jnp.float32)
    v = v.astype(jnp.float32)
    table = t5_table.astype(jnp.float32)
    key_pos = jnp.arange(L, dtype=jnp.int32)
    key_chunk = key_pos // CHUNK
    q_blocks = jnp.moveaxis(q.reshape(B_, nqb, QBLOCK, N_HEADS_A, 2, DK_A), 1, 0)

    def one_block(args):
        q_blk, blk = args
        q_pos = blk * QBLOCK + jnp.arange(QBLOCK, dtype=jnp.int32)
        bias = jnp.moveaxis(table[t5_bucket(key_pos[None, :] - q_pos[:, None])], -1, 0)
        visible = key_chunk[None, :] <= (q_pos // CHUNK)[:, None]
        s = jnp.einsum('bqhmd,bkhmd->bhmqk', q_blk, k) + bias[None, :, None]
        p = jax.nn.softmax(jnp.where(visible, s, NEG_INF), axis=-1)
        w = p[:, :, 0] - lam * p[:, :, 1]
        return jnp.einsum('bhqk,bkhd->bqhd', w, v)

    out = lax.map(one_block, (q_blocks, jnp.arange(nqb, dtype=jnp.int32)))
    out = jnp.moveaxis(out, 0, 1).reshape(B_, L, N_HEADS_A, DV_A)
    out = rmsnorm(out, subln_g) * (1.0 - lam_init)
    return out.reshape(B_, L, N_HEADS_A * DV_A)


def band_attention(q, k, v, rel_bias):
    B_, L = q.shape[0], q.shape[1]
    nc = L // CHUNK
    shp = (B_, nc, CHUNK, N_HEADS_B, DH_B)
    qc = q.astype(jnp.float32).reshape(shp) * (DH_B ** -0.5)

    def gather_band(t):
        tp = jnp.pad(t.astype(jnp.float32).reshape(shp), ((0, 0), (LEFT_CHUNKS, 0), (0, 0), (0, 0), (0, 0)))
        return jnp.concatenate([tp[:, j:j + nc] for j in range(LEFT_CHUNKS + 1)], axis=2)

    kb = gather_band(k)
    vb = gather_band(v)
    m = jnp.arange(BAND, dtype=jnp.int32)
    i = jnp.arange(CHUNK, dtype=jnp.int32)
    rel = jnp.clip(m[None, :] - LEFT_CHUNKS * CHUNK - i[:, None], -REL_CLIP, REL_CLIP) + REL_CLIP
    bias = rel_bias.astype(jnp.float32)[:, rel]
    valid = (jnp.arange(nc, dtype=jnp.int32)[:, None] - LEFT_CHUNKS + m[None, :] // CHUNK) >= 0
    s = jnp.einsum('bnqhd,bnkhd->bhnqk', qc, kb) + bias[None, :, None]
    p = jax.nn.softmax(jnp.where(valid[None, None, :, None, :], s, NEG_INF), axis=-1)
    out = jnp.einsum('bhnqk,bnkhd->bnqhd', p, vb)
    return out.reshape(B_, L, N_HEADS_B * DH_B)


def rotary(t):
    L, d = t.shape[1], t.shape[-1]
    inv_freq = 1.0 / (ROPE_BASE ** (jnp.arange(0, d, 2, dtype=jnp.float32) / d))
    ang = jnp.arange(L, dtype=jnp.float32)[:, None] * inv_freq[None, :]
    cos = jnp.cos(ang)[None, :, None, :]
    sin = jnp.sin(ang)[None, :, None, :]
    t1, t2 = jnp.split(t, 2, axis=-1)
    return jnp.concatenate([t1 * cos - t2 * sin, t1 * sin + t2 * cos], axis=-1)


def retention(q, k, v):
    B_, L = q.shape[0], q.shape[1]
    nc = L // CHUNK
    log_g = jnp.log(1.0 - jnp.power(2.0, -5.0 - jnp.arange(N_HEADS_C, dtype=jnp.float32)))
    pos = jnp.arange(CHUNK, dtype=jnp.float32)
    intra_decay = jnp.exp(log_g[:, None, None] * jnp.abs(pos[:, None] - pos[None, :]))
    q_decay = jnp.exp(log_g[:, None] * (pos[None, :] + 1.0))
    k_decay = jnp.exp(log_g[:, None] * (CHUNK - 1.0 - pos[None, :]))
    chunk_decay = jnp.exp(log_g * CHUNK)
    qc = q.reshape(B_, nc, CHUNK, N_HEADS_C, DQK_C)
    kc = k.reshape(B_, nc, CHUNK, N_HEADS_C, DQK_C) * (DQK_C ** -0.5)
    vc = v.reshape(B_, nc, CHUNK, N_HEADS_C, DV_C)
    scores = jnp.einsum('bnihd,bnjhd->bnhij', qc, kc) * intra_decay
    intra = jnp.einsum('bnhij,bnjhe->bnihe', scores, vc)
    kv = jnp.einsum('bnjhd,hj,bnjhe->bnhde', kc, k_decay, vc)

    def step(state, kv_n):
        return state * chunk_decay[None, :, None, None] + kv_n, state

    init = jnp.zeros((B_, N_HEADS_C, DQK_C, DV_C), jnp.float32)
    _, s_prev = lax.scan(step, init, jnp.moveaxis(kv, 1, 0))
    s_prev = jnp.moveaxis(s_prev, 0, 1)
    cross = jnp.einsum('bnihd,hi,bnhde->bnihe', qc, q_decay, s_prev)
    return (intra + cross).reshape(B_, L, N_HEADS_C, DV_C)


def _ssm_combine(e1, e2):
    a1, b1 = e1
    a2, b2 = e2
    return a1 * a2, a2 * b1 + b2


def s5_ssm(u, lam_re, lam_im, log_step, b_re, b_im, c_re, c_im, d_skip):
    B_, L = u.shape[0], u.shape[1]
    uf = u.astype(jnp.float32).reshape(B_, L, S5_GROUPS, S5_GROUP)
    lam = lax.complex(lam_re.astype(jnp.float32), lam_im.astype(jnp.float32))
    step = jnp.exp(log_step.astype(jnp.float32))[:, None]
    a_bar = jnp.exp(lam * step)
    b = lax.complex(b_re.astype(jnp.float32), b_im.astype(jnp.float32))
    b_bar = ((a_bar - 1.0) / lam)[..., None] * b
    bu = jnp.einsum('gnp,blgp->blgn', b_bar, uf.astype(jnp.complex64))
    a_seq = jnp.broadcast_to(a_bar, bu.shape)
    _, states = lax.associative_scan(_ssm_combine, (a_seq, bu), axis=1)
    cm = lax.complex(c_re.astype(jnp.float32), c_im.astype(jnp.float32))
    y = jnp.einsum('gpn,blgn->blgp', cm, states).real + d_skip.astype(jnp.float32).reshape(S5_GROUPS, S5_GROUP) * uf
    return y.reshape(B_, L, S5_CH)


def even_mixer(h, w_in, w_out, t5_table, lam_params, subln_g, rel_bias, lam_init):
    B_, L = h.shape[0], h.shape[1]
    wa = N_HEADS_A * DV_A
    wb = N_HEADS_B * DH_B
    proj = h @ w_in
    qa, ka, va, qb, kb, vb = jnp.split(proj, [wa, 2 * wa, 3 * wa, 3 * wa + wb, 3 * wa + 2 * wb], axis=-1)
    lp = lam_params.astype(jnp.float32)
    lam = jnp.exp(jnp.sum(lp[0] * lp[1])) - jnp.exp(jnp.sum(lp[2] * lp[3])) + lam_init
    out_a = diff_attention(qa.reshape(B_, L, N_HEADS_A, 2, DK_A), ka.reshape(B_, L, N_HEADS_A, 2, DK_A),
                           va.reshape(B_, L, N_HEADS_A, DV_A), t5_table, lam, lam_init, subln_g)
    out_b = band_attention(qb.reshape(B_, L, N_HEADS_B, DH_B), kb.reshape(B_, L, N_HEADS_B, DH_B),
                           vb.reshape(B_, L, N_HEADS_B, DH_B), rel_bias)
    return jnp.concatenate([out_a, out_b], axis=-1).astype(h.dtype) @ w_out


def odd_mixer(h, w_in, w_out, lam_re, lam_im, log_step, b_re, b_im, c_re, c_im, d_skip, glu_w):
    B_, L = h.shape[0], h.shape[1]
    wqk = N_HEADS_C * DQK_C
    wv = N_HEADS_C * DV_C
    proj = h @ w_in
    q, k, v, gate, u = jnp.split(proj, [wqk, 2 * wqk, 2 * wqk + wv, 2 * wqk + 2 * wv], axis=-1)
    q = rotary(q.astype(jnp.float32).reshape(B_, L, N_HEADS_C, DQK_C))
    k = rotary(k.astype(jnp.float32).reshape(B_, L, N_HEADS_C, DQK_C))
    r = retention(q, k, v.astype(jnp.float32).reshape(B_, L, N_HEADS_C, DV_C))
    r = rmsnorm(r).reshape(B_, L, wv) * jax.nn.silu(gate.astype(jnp.float32))
    y = jax.nn.gelu(s5_ssm(u, lam_re, lam_im, log_step, b_re, b_im, c_re, c_im, d_skip))
    ga, gb = jnp.split(y.astype(h.dtype) @ glu_w, 2, axis=-1)
    y = ga.astype(jnp.float32) * jax.nn.sigmoid(gb.astype(jnp.float32))
    return jnp.concatenate([r, y], axis=-1).astype(h.dtype) @ w_out


def conv_ffn(h, w_in, conv_w, conv_b, w_out):
    up = h @ w_in
    val, gate = jnp.split(up, 2, axis=-1)
    gate = lax.conv_general_dilated(gate, conv_w[:, None, :], (1,), [(CONV_W - 1, 0)],
                                    dimension_numbers=('NWC', 'WIO', 'NWC'),
                                    feature_group_count=D_FF) + conv_b
    return (jax.nn.gelu(gate) * val) @ w_out


def setup_inputs(seed: int = 0) -> dict:
    key = jax.random.key(seed)
    ks = jax.random.split(key, 32)
    f32 = jnp.float32

    def nrm(i, shape, scale):
        return scale * jax.random.normal(ks[i], shape, f32)

    n_idx = jnp.arange(S5_STATE, dtype=f32)
    return {
        'x': nrm(0, (BATCH, SEQ, D_MODEL), 1.0),
        'c': nrm(1, (BATCH, D_MODEL), 1.0),
        't5_table': nrm(2, (NUM_BUCKETS, N_HEADS_A), 0.5),
        'mod_w': nrm(3, (DEPTH, D_MODEL, 6 * D_MODEL), 0.5 * D_MODEL ** -0.5),
        'mod_b': nrm(4, (DEPTH, 6 * D_MODEL), 0.02),
        'norm1_g': 1.0 + nrm(5, (DEPTH, D_MODEL), 0.02),
        'norm2_g': 1.0 + nrm(6, (DEPTH, D_MODEL), 0.02),
        'ffn_w_in': nrm(7, (DEPTH, D_MODEL, 2 * D_FF), D_MODEL ** -0.5),
        'ffn_conv_w': nrm(8, (DEPTH, CONV_W, D_FF), CONV_W ** -0.5),
        'ffn_conv_b': nrm(9, (DEPTH, D_FF), 0.02),
        'ffn_w_out': nrm(10, (DEPTH, D_FF, D_MODEL), D_FF ** -0.5),
        'ev_w_in': nrm(11, (N_EVEN, D_MODEL, EVEN_IN), D_MODEL ** -0.5),
        'ev_w_out': nrm(12, (N_EVEN, 2 * GROUP_WIDTH, D_MODEL), (2 * GROUP_WIDTH) ** -0.5),
        'diff_lambda': nrm(13, (N_EVEN, 4, DK_A), 0.1),
        'diff_subln_g': 1.0 + nrm(14, (N_EVEN, DV_A), 0.02),
        'band_rel_bias': nrm(15, (N_EVEN, N_HEADS_B, 2 * REL_CLIP + 1), 0.5),
        'od_w_in': nrm(16, (N_ODD, D_MODEL, ODD_IN), D_MODEL ** -0.5),
        'od_w_out': nrm(17, (N_ODD, 2 * GROUP_WIDTH, D_MODEL), (2 * GROUP_WIDTH) ** -0.5),
        's5_lam_re': -0.5 + nrm(18, (N_ODD, S5_GROUPS, S5_STATE), 0.01),
        's5_lam_im': math.pi * n_idx + nrm(19, (N_ODD, S5_GROUPS, S5_STATE), 0.01),
        's5_log_step': jax.random.uniform(ks[20], (N_ODD, S5_GROUPS), f32, math.log(1e-3), math.log(1e-1)),
        's5_b_re': nrm(21, (N_ODD, S5_GROUPS, S5_STATE, S5_GROUP), (2 * S5_GROUP) ** -0.5),
        's5_b_im': nrm(22, (N_ODD, S5_GROUPS, S5_STATE, S5_GROUP), (2 * S5_GROUP) ** -0.5),
        's5_c_re': nrm(23, (N_ODD, S5_GROUPS, S5_GROUP, S5_STATE), (2 * S5_STATE) ** -0.5),
        's5_c_im': nrm(24, (N_ODD, S5_GROUPS, S5_GROUP, S5_STATE), (2 * S5_STATE) ** -0.5),
        's5_d': nrm(25, (N_ODD, S5_CH), 1.0),
        's5_glu_w': nrm(26, (N_ODD, S5_CH, 2 * S5_CH), S5_CH ** -0.5),
        'final_g': 1.0 + nrm(27, (D_MODEL,), 0.02),
    }


def reference(x, c, t5_table, mod_w, mod_b, norm1_g, norm2_g, ffn_w_in, ffn_conv_w, ffn_conv_b, ffn_w_out,
              ev_w_in, ev_w_out, diff_lambda, diff_subln_g, band_rel_bias,
              od_w_in, od_w_out, s5_lam_re, s5_lam_im, s5_log_step, s5_b_re, s5_b_im, s5_c_re, s5_c_im,
              s5_d, s5_glu_w, final_g):
    cond = jax.nn.silu(c)
    for i in range(DEPTH):
        mod = cond @ mod_w[i] + mod_b[i]
        sh1, sc1, g1, sh2, sc2, g2 = jnp.split(mod, 6, axis=-1)
        h = modulated_rmsnorm(x, norm1_g[i], sh1, sc1)
        if i % 2 == 0:
            e = i // 2
            lam_init = 0.8 - 0.6 * math.exp(-0.3 * i)
            mixed = even_mixer(h, ev_w_in[e], ev_w_out[e], t5_table, diff_lambda[e], diff_subln_g[e],
                               band_rel_bias[e], lam_init)
        else:
            o = i // 2
            mixed = odd_mixer(h, od_w_in[o], od_w_out[o], s5_lam_re[o], s5_lam_im[o], s5_log_step[o],
                              s5_b_re[o], s5_b_im[o], s5_c_re[o], s5_c_im[o], s5_d[o], s5_glu_w[o])
        x = x + g1[:, None, :] * mixed
        h = modulated_rmsnorm(x, norm2_g[i], sh2, sc2)
        x = x + g2[:, None, :] * conv_ffn(h, ffn_w_in[i], ffn_conv_w[i], ffn_conv_b[i], ffn_w_out[i])
    return rmsnorm(x, final_g).astype(x.dtype)
```

```cpp
#include <hip/hip_runtime.h>
#include <hip/hip_cooperative_groups.h>
#include <cstdio>
#include <cstdint>
namespace cg = cooperative_groups;
__device__ __forceinline__ int tid_opaque() { int t = threadIdx.x; asm volatile("" : "+v"(t)); return t; }
namespace pg8 {
#define PG8_LAS __attribute__((address_space(3)))
typedef unsigned short bf16_t;
typedef short bf16x8 __attribute__((ext_vector_type(8)));
typedef float f32x4 __attribute__((ext_vector_type(4)));
typedef unsigned u32x4 __attribute__((ext_vector_type(4)));
constexpr int BM = 256, BK = 64, HALF = 128, HTB = HALF * BK * 2  , STAGE_BYTES = 8 * HTB, NXCD = 8, WGM = 8;

__host__ __device__ __forceinline__ int lds_byte(int r, int c) { const int st = (r >> 4) * 2 + (c >> 5), rr = r & 15, cc = c & 31, ob = rr * 64 + cc * 2; return st * 1024 + (ob ^ (((ob >> 9) & 1) << 5)); }
__host__ __device__ __forceinline__ void stage_rc(int b, int& R, int& C) { const int st = b / 1024, sb = b % 1024, swz = sb ^ (((sb >> 9) & 1) << 5); R = (st >> 1) * 16 + swz / 64; C = (st & 1) * 32 + (swz % 64) / 2; }
__host__ __device__ __forceinline__ int perm32(int rho) { const int n = rho >> 4, i = rho & 15; return 8 * (i >> 2) + 4 * n + (i & 3); }

struct Unit { int pm, pn; };
struct Gemm { const bf16_t* A; const bf16_t* Bt; int M, N, K; };

struct StaticOrder {
    int nM, nN, nwg, G, c;
    __host__ __device__ void init(int M, int N, int G_, int c_) { nM = M / BM; nN = N / BM; nwg = nM * nN; G = G_; c = c_; }
    __host__ __device__ bool next(int i, Unit& u) const {
        const long L = (long)i * G + c; if (L >= nwg) return false;
        int wgid = (int)L; { const int q = nwg / NXCD, r = nwg % NXCD, xcd = wgid % NXCD, off = wgid / NXCD; wgid = (xcd < r ? xcd * (q + 1) : r * (q + 1) + (xcd - r) * q) + off; }
        const int nig = WGM * nN, gid = wgid / nig, fm = gid * WGM, gsz = (nM - fm) < WGM ? (nM - fm) : WGM;
        u.pm = fm + ((wgid % nig) % gsz); u.pn = (wgid % nig) / gsz; return true;
    }
    __device__ __forceinline__ void a_ready(const Unit&) const {}
    __device__ __forceinline__ void done(const Unit&) const {}
};

__device__ __forceinline__ unsigned cvt_pk_bf16(float lo, float hi) { unsigned r; asm volatile("v_cvt_pk_bf16_f32 %0, %1, %2" : "=v"(r) : "v"(lo), "v"(hi)); return r; }
typedef float f32x2 __attribute__((ext_vector_type(2)));
constexpr float RMS_EPS = 1e-6f;
constexpr float C2Q = 0.125f * 1.4426950408889634f;
typedef unsigned u32x2 __attribute__((ext_vector_type(2)));
__device__ __forceinline__ float fast_sigmoid(float x) { return __builtin_amdgcn_rcpf(1.0f + __builtin_amdgcn_exp2f(-1.4426950408889634f * x)); }
__device__ __forceinline__ float gelu_tanh(float x) { const float u = 0.7978845608028654f * (x + 0.044715f * x * x * x); return x * __builtin_amdgcn_rcpf(1.0f + __builtin_amdgcn_exp2f(-2.8853900817779268f * u)); }
__device__ __forceinline__ float rs_of(const float* p16, int fq) { const f32x4 a = *(const f32x4*)(p16 + 4 * fq);
    float ss = (a[0] + a[1]) + (a[2] + a[3]); ss += __shfl_xor(ss, 16); ss += __shfl_xor(ss, 32);
    return 1.0f / sqrtf(ss * (1.0f / 1024.0f) + RMS_EPS); }
struct EpiProj {
    static constexpr bool PERM = true, AFTER_DRAIN = false;
    bf16_t* O; int ldc; const float* bv; const float* rowss; unsigned qmask;
    __device__ __forceinline__ void operator()(const f32x4 (&acc)[2][2][4][2], const Unit& u, int wr, int wc, int fr, int fq) const {
        const int row0 = u.pm * BM + wr * 64 + fr, col0 = u.pn * BM + wc * 32 + 8 * fq;
        const float sc = ((qmask >> u.pn) & 1u) ? C2Q : 1.0f;
        f32x4 bvv[2][2];
#pragma unroll
        for (int bj = 0; bj < 2; ++bj)
#pragma unroll
            for (int n = 0; n < 2; ++n) bvv[bj][n] = *(const f32x4*)(bv + col0 + bj * HALF + 4 * n);
#pragma unroll
        for (int ai = 0; ai < 2; ++ai)
#pragma unroll
            for (int m = 0; m < 4; ++m) { const int row = row0 + ai * HALF + m * 16; const float rs = rs_of(rowss + (size_t)row * 16, fq); bf16_t* rowp = O + (size_t)row * ldc + col0;
#pragma unroll
                for (int bj = 0; bj < 2; ++bj) { const f32x4 v0 = (acc[ai][bj][m][0] * rs + bvv[bj][0]) * sc, v1 = (acc[ai][bj][m][1] * rs + bvv[bj][1]) * sc;
                    u32x4 w; w.x = cvt_pk_bf16(v0[0], v0[1]); w.y = cvt_pk_bf16(v0[2], v0[3]); w.z = cvt_pk_bf16(v1[0], v1[1]); w.w = cvt_pk_bf16(v1[2], v1[3]);
                    *(u32x4*)(rowp + bj * HALF) = w; } }
    }
};
struct EpiRope {
    static constexpr bool PERM = true, AFTER_DRAIN = false;
    bf16_t* O; int ldc; const float* bv; const float* rowss; const float* rope;
    __device__ __forceinline__ void operator()(const f32x4 (&acc)[2][2][4][2], const Unit& u, int wr, int wc, int fr, int fq) const {
        const int row0 = u.pm * BM + wr * 64 + fr, col0 = u.pn * BM + wc * 32 + 8 * fq;
        const bool rot = u.pn < 2; const float sc = (u.pn == 1) ? 0.125f : 1.0f;
        const int i0 = 16 * (wc & 1) + 4 * fq;
        f32x4 bvv[2][2];
#pragma unroll
        for (int bj = 0; bj < 2; ++bj)
#pragma unroll
            for (int n = 0; n < 2; ++n) bvv[bj][n] = *(const f32x4*)(bv + col0 + bj * HALF + 4 * n);
#pragma unroll
        for (int ai = 0; ai < 2; ++ai)
#pragma unroll
            for (int m = 0; m < 4; ++m) { const int row = row0 + ai * HALF + m * 16; const float rs = rs_of(rowss + (size_t)row * 16, fq); bf16_t* rowp = O + (size_t)row * ldc + col0;
                f32x4 cs0 = (f32x4){1.f, 0.f, 1.f, 0.f}, cs1 = cs0;
                if (rot) { const f32x4* rp = (const f32x4*)(rope + ((size_t)row * 32 + i0) * 2); cs0 = rp[0]; cs1 = rp[1]; }
#pragma unroll
                for (int bj = 0; bj < 2; ++bj) { f32x4 v0 = acc[ai][bj][m][0] * rs + bvv[bj][0], v1 = acc[ai][bj][m][1] * rs + bvv[bj][1];
                    if (rot) {
                        f32x4 r0, r1;
                        r0[0] = v0[0] * cs0[0] - v0[1] * cs0[1]; r0[1] = v0[0] * cs0[1] + v0[1] * cs0[0];
                        r0[2] = v0[2] * cs0[2] - v0[3] * cs0[3]; r0[3] = v0[2] * cs0[3] + v0[3] * cs0[2];
                        r1[0] = v1[0] * cs1[0] - v1[1] * cs1[1]; r1[1] = v1[0] * cs1[1] + v1[1] * cs1[0];
                        r1[2] = v1[2] * cs1[2] - v1[3] * cs1[3]; r1[3] = v1[2] * cs1[3] + v1[3] * cs1[2];
                        v0 = r0 * sc; v1 = r1 * sc; }
                    u32x4 w; w.x = cvt_pk_bf16(v0[0], v0[1]); w.y = cvt_pk_bf16(v0[2], v0[3]); w.z = cvt_pk_bf16(v1[0], v1[1]); w.w = cvt_pk_bf16(v1[2], v1[3]);
                    *(u32x4*)(rowp + bj * HALF) = w; } }
    }
};
struct EpiRes {
    static constexpr bool PERM = true, AFTER_DRAIN = false;
    const float* xin; float* xout; const float* gate; const float* gm; bf16_t* AP; float* rowss;
    __device__ __forceinline__ void operator()(const f32x4 (&acc)[2][2][4][2], const Unit& u, int wr, int wc, int fr, int fq) const {
        const int row0 = u.pm * BM + wr * 64 + fr, col0 = u.pn * BM + wc * 32 + 8 * fq;
        f32x4 gv[2][2], gmv[2][2];
#pragma unroll
        for (int bj = 0; bj < 2; ++bj)
#pragma unroll
            for (int n = 0; n < 2; ++n) { gv[bj][n] = *(const f32x4*)(gate + col0 + bj * HALF + 4 * n); gmv[bj][n] = gm ? *(const f32x4*)(gm + col0 + bj * HALF + 4 * n) : (f32x4){0.f, 0.f, 0.f, 0.f}; }
#pragma unroll
        for (int ai = 0; ai < 2; ++ai)
#pragma unroll
            for (int m = 0; m < 4; ++m) { const int row = row0 + ai * HALF + m * 16; const size_t off = (size_t)row * 1024 + col0; float ss = 0.f;
#pragma unroll
                for (int bj = 0; bj < 2; ++bj) {
                    const f32x4 x0 = *(const f32x4*)(xin + off + bj * HALF) + gv[bj][0] * acc[ai][bj][m][0];
                    const f32x4 x1 = *(const f32x4*)(xin + off + bj * HALF + 4) + gv[bj][1] * acc[ai][bj][m][1];
                    *(f32x4*)(xout + off + bj * HALF) = x0; *(f32x4*)(xout + off + bj * HALF + 4) = x1;
                    ss += (x0[0] * x0[0] + x0[1] * x0[1]) + (x0[2] * x0[2] + x0[3] * x0[3]) + (x1[0] * x1[0] + x1[1] * x1[1]) + (x1[2] * x1[2] + x1[3] * x1[3]);
                    if (gm) { const f32x4 a0 = x0 * gmv[bj][0], a1 = x1 * gmv[bj][1];
                        u32x4 w; w.x = cvt_pk_bf16(a0[0], a0[1]); w.y = cvt_pk_bf16(a0[2], a0[3]); w.z = cvt_pk_bf16(a1[0], a1[1]); w.w = cvt_pk_bf16(a1[2], a1[3]);
                        *(u32x4*)(AP + off + bj * HALF) = w; } }
                ss += __shfl_xor(ss, 16); ss += __shfl_xor(ss, 32);
                if (fq == 0) rowss[(size_t)row * 16 + u.pn * 4 + wc] = ss; }
    }
};
struct EpiGlu {
    static constexpr bool PERM = true, AFTER_DRAIN = false;
    bf16_t* O; int ldc; int ocol0;
    __device__ __forceinline__ void operator()(const f32x4 (&acc)[2][2][4][2], const Unit& u, int wr, int wc, int fr, int fq) const {
        const int row0 = u.pm * BM + wr * 64 + fr, col0 = ocol0 + u.pn * HALF + wc * 32 + 8 * fq;
#pragma unroll
        for (int ai = 0; ai < 2; ++ai)
#pragma unroll
            for (int m = 0; m < 4; ++m) { const int row = row0 + ai * HALF + m * 16;
                f32x4 y0, y1;
#pragma unroll
                for (int j = 0; j < 4; ++j) { y0[j] = acc[ai][0][m][0][j] * fast_sigmoid(acc[ai][1][m][0][j]); y1[j] = acc[ai][0][m][1][j] * fast_sigmoid(acc[ai][1][m][1][j]); }
                u32x4 w; w.x = cvt_pk_bf16(y0[0], y0[1]); w.y = cvt_pk_bf16(y0[2], y0[3]); w.z = cvt_pk_bf16(y1[0], y1[1]); w.w = cvt_pk_bf16(y1[2], y1[3]);
                *(u32x4*)(O + (size_t)row * ldc + col0) = w; }
    }
};
struct EpiFfn {
    static constexpr bool PERM = true, AFTER_DRAIN = false;
    bf16_t* ACT; const float* bv; const float* rowss; const float* cw; const float* cb; float* headv; float* headg; float* tailg; PG8_LAS float* xg;
    __device__ __forceinline__ void operator()(const f32x4 (&acc)[2][2][4][2], const Unit& u, int wr, int wc, int fr, int fq) const {
        const int lane = (fq << 4) | fr;
        const int lc = wc * 32 + 8 * fq, f0 = u.pn * HALF + lc, pc0 = u.pn * BM + lc;
        float rs[2][4];
#pragma unroll
        for (int ai = 0; ai < 2; ++ai)
#pragma unroll
            for (int m = 0; m < 4; ++m) rs[ai][m] = rs_of(rowss + (size_t)(u.pm * BM + ai * HALF + wr * 64 + m * 16 + fr) * 16, fq);
        if (fr >= 14) {
#pragma unroll
            for (int n = 0; n < 2; ++n) { const f32x4 bvg = *(const f32x4*)(bv + pc0 + HALF + 4 * n);
#pragma unroll
                for (int ai = 0; ai < 2; ++ai) { const f32x4 g3 = acc[ai][1][3][n] * rs[ai][3] + bvg;
                    *(PG8_LAS f32x4*)(xg + ((2 * ai + wr) * 2 + (fr - 14)) * 128 + lc + 4 * n) = g3;
                    if (ai == 1 && wr == 1) *(f32x4*)(tailg + (size_t)(u.pm * 2 + (fr - 14)) * 2816 + f0 + 4 * n) = g3; } }
        }
        asm volatile("s_waitcnt lgkmcnt(0)" ::: "memory"); __builtin_amdgcn_s_barrier(); asm volatile("" ::: "memory");
        const int src1 = (lane & 48) | ((fr + 15) & 15), src2 = (lane & 48) | ((fr + 14) & 15);
        u32x2 pk0[2][4];
#pragma unroll
        for (int n = 0; n < 2; ++n) {
            const f32x4 w0 = *(const f32x4*)(cw + f0 + 4 * n), w1 = *(const f32x4*)(cw + 2816 + f0 + 4 * n), w2 = *(const f32x4*)(cw + 5632 + f0 + 4 * n), cbv = *(const f32x4*)(cb + f0 + 4 * n);
            const f32x4 bvv = *(const f32x4*)(bv + pc0 + 4 * n), bvg = *(const f32x4*)(bv + pc0 + HALF + 4 * n);
#pragma unroll
            for (int ai = 0; ai < 2; ++ai) {
                const int b = 2 * ai + wr;
                f32x4 P1 = (f32x4){0.f, 0.f, 0.f, 0.f}, P2 = P1;
                if (b >= 1) { P2 = *(const PG8_LAS f32x4*)(xg + ((b - 1) * 2 + 0) * 128 + lc + 4 * n); P1 = *(const PG8_LAS f32x4*)(xg + ((b - 1) * 2 + 1) * 128 + lc + 4 * n); }
                f32x4 s1p = P1, s2p = (fr == 1) ? P1 : P2;
#pragma unroll
                for (int m = 0; m < 4; ++m) {
                    const int row = u.pm * BM + ai * HALF + wr * 64 + m * 16 + fr;
                    const bool head = (b == 0) && (m == 0) && (fr < 2) && (u.pm > 0);
                    const f32x4 g = acc[ai][1][m][n] * rs[ai][m] + bvg;
                    const f32x4 val = acc[ai][0][m][n] * rs[ai][m] + bvv;
                    f32x4 s1, s2;
#pragma unroll
                    for (int j = 0; j < 4; ++j) { s1[j] = __shfl(g[j], src1); s2[j] = __shfl(g[j], src2); }
                    const f32x4 p1 = (fr >= 1) ? s1 : s1p, p2 = (fr >= 2) ? s2 : s2p;
                    s1p = s1; s2p = s2;
                    const f32x4 cv = w0 * p2 + w1 * p1 + w2 * g + cbv;
                    f32x4 av;
#pragma unroll
                    for (int j = 0; j < 4; ++j) av[j] = gelu_tanh(cv[j]) * val[j];
                    if (head) { *(f32x4*)(headv + (size_t)(u.pm * 2 + fr) * 2816 + f0 + 4 * n) = val; *(f32x4*)(headg + (size_t)(u.pm * 2 + fr) * 2816 + f0 + 4 * n) = g; }
                    const u32x2 pk = (u32x2){cvt_pk_bf16(av[0], av[1]), cvt_pk_bf16(av[2], av[3])};
                    if (n == 0) pk0[ai][m] = pk;
                    else if (!head) { u32x4 w; w.x = pk0[ai][m].x; w.y = pk0[ai][m].y; w.z = pk.x; w.w = pk.y; *(u32x4*)(ACT + (size_t)row * 2816 + f0) = w; }
                }
            }
        }
    }
};
template <class Epi, class Sched, bool ALIGN_EPI = false, bool SP2 = false>
__device__ __forceinline__ void gemm_phase(PG8_LAS unsigned char* lds, const Gemm g, const Sched& S, const Epi& E) {
    const int tid = tid_opaque(), wid = __builtin_amdgcn_readfirstlane(tid >> 6), lane = tid & 63, wr = wid >> 2, wc = wid & 3, fr = lane & 15, fq = lane >> 4;
    const int K = g.K, nt = K / BK;
    unsigned voffA[2], voffB[2];
#pragma unroll
    for (int i = 0; i < 2; ++i) { int R, C; stage_rc(tid * 16 + i * 8192, R, C); const int Rb = Epi::PERM ? ((R & ~31) + perm32(R & 31)) : R;
        voffA[i] = (unsigned)(R * K + C) * 2u; voffB[i] = (unsigned)(Rb * K + C) * 2u; }
    const size_t kstep = (size_t)(BK * 2);
    const size_t hstep = (size_t)HALF * K * 2;
    const size_t tstep = 2 * hstep;
    const unsigned ldsw = (unsigned)wid * 1024u;
    const int aoff = lds_byte(wr * 64 + fr, fq * 8), boff = lds_byte(wc * 32 + fr, fq * 8);
#define PG8_SA(b, h) (((b) * 2 + (h)) * HTB)
#define PG8_SB(b, h) ((4 + (b) * 2 + (h)) * HTB)
#define PG8_STAGE(bufoff, gbase, voff) do { _Pragma("unroll") for (int _i = 0; _i < 2; ++_i) { unsigned _vo = (voff)[_i]; asm volatile("" : "+v"(_vo)); \
        __builtin_amdgcn_global_load_lds((const unsigned*)((const char*)(gbase) + _vo), (PG8_LAS unsigned*)(lds + (bufoff) + ldsw + _i * 8192), 16, 0, 0); } } while (0)
#define PG8_LDA(dst, b, h) do { _Pragma("unroll") for (int m = 0; m < 4; ++m) _Pragma("unroll") for (int k = 0; k < 2; ++k) dst[m][k] = *(const PG8_LAS bf16x8*)(lds + PG8_SA(b, h) + aoff + m * 2048 + k * 1024); } while (0)
#define PG8_LDB(dst, b, h) do { _Pragma("unroll") for (int n = 0; n < 2; ++n) _Pragma("unroll") for (int k = 0; k < 2; ++k) dst[n][k] = *(const PG8_LAS bf16x8*)(lds + PG8_SB(b, h) + boff + n * 2048 + k * 1024); } while (0)
#define PG8_MMA(ai, bj, At, Bt) do { __builtin_amdgcn_s_setprio(1); _Pragma("unroll") for (int m = 0; m < 4; ++m) _Pragma("unroll") for (int n = 0; n < 2; ++n) _Pragma("unroll") for (int k = 0; k < 2; ++k) \
        acc[ai][bj][m][n] = __builtin_amdgcn_mfma_f32_16x16x32_bf16(Bt[n][k], At[m][k], acc[ai][bj][m][n], 0, 0, 0); __builtin_amdgcn_s_setprio(0); } while (0)
#define PG8_WAIT_V(n) asm volatile("s_waitcnt vmcnt(" #n ")" ::: "memory")
#define PG8_WAIT_L(n) asm volatile("s_waitcnt lgkmcnt(" #n ")" ::: "memory")
#define PG8_BAR do { asm volatile("" ::: "memory"); __builtin_amdgcn_s_barrier(); asm volatile("" ::: "memory"); } while (0)
#define PG8_SCHED __builtin_amdgcn_sched_barrier(0)
    Unit cur, nxt; int ui = 0;
    if (!S.next(0, cur)) return;
    f32x4 acc[2][2][4][2];
#pragma unroll
    for (int a = 0; a < 2; ++a)
#pragma unroll
        for (int b = 0; b < 2; ++b)
#pragma unroll
            for (int m = 0; m < 4; ++m)
#pragma unroll
                for (int n = 0; n < 2; ++n) acc[a][b][m][n] = (f32x4){0.f, 0.f, 0.f, 0.f};
    bf16x8 At[4][2], B0[2][2], B1[2][2];
    const char* cA = (const char*)g.A + (size_t)cur.pm * tstep; const char* cB = (const char*)g.Bt + (size_t)cur.pn * tstep;
    S.a_ready(cur);
    if constexpr (SP2) {
        PG8_STAGE(PG8_SB(0, 0), cB, voffB); PG8_STAGE(PG8_SB(0, 1), cB + hstep, voffB); PG8_STAGE(PG8_SA(0, 0), cA, voffA); PG8_STAGE(PG8_SA(0, 1), cA + hstep, voffA);
        if (wr == 1) PG8_BAR;
        PG8_WAIT_V(2); PG8_BAR;
        PG8_STAGE(PG8_SB(1, 0), cB + kstep, voffB); PG8_STAGE(PG8_SA(1, 0), cA + kstep, voffA); PG8_STAGE(PG8_SB(1, 1), cB + hstep + kstep, voffB);
        PG8_WAIT_V(6); PG8_BAR;
    } else {
        PG8_STAGE(PG8_SB(0, 0), cB, voffB); PG8_STAGE(PG8_SA(0, 0), cA, voffA); PG8_STAGE(PG8_SB(0, 1), cB + hstep, voffB); PG8_STAGE(PG8_SA(0, 1), cA + hstep, voffA);
        if (wr == 1) PG8_BAR;
        PG8_WAIT_V(4); PG8_BAR;
        PG8_STAGE(PG8_SB(1, 0), cB + kstep, voffB); PG8_STAGE(PG8_SA(1, 0), cA + kstep, voffA); PG8_STAGE(PG8_SB(1, 1), cB + hstep + kstep, voffB);
        PG8_WAIT_V(6); PG8_BAR;
    }
    for (;;) {
        const bool has_next = S.next(ui + 1, nxt);
        const char* nA = has_next ? (const char*)g.A + (size_t)nxt.pm * tstep : cA; const char* nB = has_next ? (const char*)g.Bt + (size_t)nxt.pn * tstep : cB;
        for (int t = 0; t < nt; t += 2) {
            const bool last = (t == nt - 2);
            const char* a1 = cA + (size_t)(t + 1) * kstep;
            const char* a2 = last ? nA : cA + (size_t)(t + 2) * kstep; const char* b2 = last ? nB : cB + (size_t)(t + 2) * kstep;
            const char* a3 = a2 + kstep; const char* b3 = b2 + kstep;
            if (last && has_next) S.a_ready(nxt);
            if constexpr (SP2) {
            PG8_LDB(B0, 0, 0); PG8_LDB(B1, 0, 1); PG8_SCHED; PG8_LDA(At, 0, 0); PG8_STAGE(PG8_SA(1, 1), a1 + hstep, voffA);
            PG8_WAIT_V(8); PG8_WAIT_L(0); PG8_BAR; PG8_MMA(0, 0, At, B0); PG8_MMA(0, 1, At, B1); PG8_BAR; PG8_SCHED;
            PG8_LDA(At, 0, 1); PG8_STAGE(PG8_SB(0, 0), b2, voffB); PG8_STAGE(PG8_SB(0, 1), b2 + hstep, voffB); PG8_STAGE(PG8_SA(0, 0), a2, voffA);
            PG8_WAIT_V(8); PG8_WAIT_L(0); PG8_BAR; PG8_MMA(1, 0, At, B0); PG8_MMA(1, 1, At, B1); PG8_BAR; PG8_SCHED;
            PG8_LDB(B0, 1, 0); PG8_LDB(B1, 1, 1); PG8_SCHED; PG8_LDA(At, 1, 0); PG8_STAGE(PG8_SA(0, 1), a2 + hstep, voffA);
            PG8_WAIT_V(8); PG8_WAIT_L(0); PG8_BAR; PG8_MMA(0, 0, At, B0); PG8_MMA(0, 1, At, B1); PG8_BAR; PG8_SCHED;
            PG8_LDA(At, 1, 1); PG8_STAGE(PG8_SB(1, 0), b3, voffB); PG8_STAGE(PG8_SB(1, 1), b3 + hstep, voffB); PG8_STAGE(PG8_SA(1, 0), a3, voffA);
            PG8_WAIT_V(8); PG8_WAIT_L(0); PG8_BAR; PG8_MMA(1, 0, At, B0); PG8_MMA(1, 1, At, B1); PG8_BAR; PG8_SCHED;
            } else {
            PG8_LDB(B0, 0, 0); PG8_SCHED; PG8_LDA(At, 0, 0); PG8_STAGE(PG8_SA(1, 1), a1 + hstep, voffA);
            PG8_WAIT_L(8); PG8_BAR; PG8_WAIT_L(0); PG8_MMA(0, 0, At, B0); PG8_BAR; PG8_SCHED;
            PG8_LDB(B1, 0, 1); PG8_STAGE(PG8_SB(0, 0), b2, voffB);
            PG8_BAR; PG8_WAIT_L(0); PG8_MMA(0, 1, At, B1); PG8_BAR;
            PG8_LDA(At, 0, 1); PG8_STAGE(PG8_SA(0, 0), a2, voffA);
            PG8_BAR; PG8_WAIT_L(0); PG8_MMA(1, 0, At, B0); PG8_BAR; PG8_SCHED;
            PG8_STAGE(PG8_SB(0, 1), b2 + hstep, voffB);
            PG8_WAIT_V(6); PG8_BAR; PG8_MMA(1, 1, At, B1); PG8_BAR;
            PG8_LDB(B0, 1, 0); PG8_SCHED; PG8_LDA(At, 1, 0); PG8_STAGE(PG8_SA(0, 1), a2 + hstep, voffA);
            PG8_WAIT_L(8); PG8_BAR; PG8_WAIT_L(0); PG8_MMA(0, 0, At, B0); PG8_BAR; PG8_SCHED;
            PG8_LDB(B1, 1, 1); PG8_STAGE(PG8_SB(1, 0), b3, voffB);
            PG8_BAR; PG8_WAIT_L(0); PG8_MMA(0, 1, At, B1); PG8_BAR;
            PG8_LDA(At, 1, 1); PG8_STAGE(PG8_SA(1, 0), a3, voffA);
            PG8_BAR; PG8_WAIT_L(0); PG8_MMA(1, 0, At, B0); PG8_BAR; PG8_SCHED;
            PG8_STAGE(PG8_SB(1, 1), b3 + hstep, voffB);
            PG8_WAIT_V(6); PG8_BAR; PG8_MMA(1, 1, At, B1); PG8_BAR;
            }
        }
        if constexpr (ALIGN_EPI) { if (wr == 0) PG8_BAR; }
        if constexpr (!Epi::AFTER_DRAIN) { E(acc, cur, wr, wc, fr, fq); S.done(cur); }
        if (!has_next) break;
#pragma unroll
        for (int a = 0; a < 2; ++a)
#pragma unroll
            for (int b = 0; b < 2; ++b)
#pragma unroll
                for (int m = 0; m < 4; ++m)
#pragma unroll
                    for (int n = 0; n < 2; ++n) acc[a][b][m][n] = (f32x4){0.f, 0.f, 0.f, 0.f};
        cur = nxt; cA = nA; cB = nB; ++ui;
        if constexpr (ALIGN_EPI) { if (wr == 1) PG8_BAR; }
    }
    PG8_WAIT_V(0);
    if constexpr (!ALIGN_EPI) { if (wr == 0) PG8_BAR; }
    PG8_BAR;
    if constexpr (Epi::AFTER_DRAIN) { E.fused(acc, cur, wr, wc, fr, fq, lds, wid, lane); S.done(cur); }
#undef PG8_SA
#undef PG8_SB
#undef PG8_STAGE
#undef PG8_LDA
#undef PG8_LDB
#undef PG8_MMA
#undef PG8_WAIT_V
#undef PG8_WAIT_L
#undef PG8_BAR
#undef PG8_SCHED
}
}
#define LAS __attribute__((address_space(3)))
typedef unsigned short bf16_t;
typedef short bf16x8 __attribute__((ext_vector_type(8)));
typedef short s16x4 __attribute__((ext_vector_type(4)));
typedef float f32x4 __attribute__((ext_vector_type(4)));
typedef float f32x2 __attribute__((ext_vector_type(2)));
typedef float f32x16 __attribute__((ext_vector_type(16)));
typedef unsigned u32x4 __attribute__((ext_vector_type(4)));
typedef unsigned u32x2 __attribute__((ext_vector_type(2)));
typedef short v4i16_t __attribute__((ext_vector_type(4)));

constexpr int L = 16384, DM = 1024, DFF = 2816, NW = 8;
constexpr int EV_IN = 3072, OD_IN = 2048;
constexpr float EPS = 1e-6f;
constexpr size_t MiB = 1u << 20;
constexpr size_t WS_WEVIN = 0, WS_WEVOUT = 6 * MiB, WS_WODIN = 8 * MiB, WS_WODOUT = 12 * MiB, WS_WGLU = 14 * MiB, WS_WFFIN = 15 * MiB, WS_WFFOUT = 37 * MiB;
constexpr size_t WFFIN_STRIDE = (size_t)5632 * 1024 * 2, WFFOUT_STRIDE = (size_t)1024 * 2816 * 2;
constexpr size_t WS_AP = 48 * MiB;
constexpr size_t WS_PROJ = 80 * MiB;
constexpr size_t WS_YG = WS_PROJ + 64 * MiB;
constexpr size_t WS_CAT = 176 * MiB;
constexpr size_t WS_MODP = 208 * MiB;
constexpr size_t WS_MOD = 210 * MiB;
constexpr size_t WS_GM = WS_MOD + 64 * 1024;
constexpr size_t WS_BV = WS_GM + 64 * 1024;
constexpr size_t WS_ROWSS = 242 * MiB;
constexpr size_t WS_ROPE = 212 * MiB;
constexpr size_t WS_HEADV = 216 * MiB, WS_HEADG = 218 * MiB, WS_TAILG = 220 * MiB;
constexpr size_t WS_RETL = 222 * MiB, WS_RETC = 230 * MiB;
constexpr size_t WS_S5L = 238 * MiB, WS_S5C = 239 * MiB;
constexpr size_t WS_S5P = 240 * MiB;
constexpr size_t WS_S5A = WS_S5P + 64 * 1024;
constexpr size_t WS_END = 248 * MiB;
constexpr int LDS_STAGE = 131072;
constexpr int LDS_XG = 131072;
constexpr int LDS_BYTES = 147456;

struct Args { const float* in[28]; float* out; unsigned char* ws; };
typedef __attribute__((address_space(4))) const unsigned char* kptr_t;
__device__ __forceinline__ kptr_t kargs_fresh() { kptr_t p = (kptr_t)__builtin_amdgcn_kernarg_segment_ptr(); asm volatile("" : "+s"(p)); return p; }
__device__ __forceinline__ kptr_t klaunder(kptr_t p) { asm volatile("" : "+s"(p)); return p; }
__device__ __forceinline__ const float* karg_in(kptr_t kp, int i) { return (const float*)(*(__attribute__((address_space(1))) const float* const __attribute__((address_space(4)))*)(kp + 8 * i)); }
__device__ __forceinline__ float* karg_out(kptr_t kp) { return (float*)(*(__attribute__((address_space(1))) float* const __attribute__((address_space(4)))*)(kp + 224)); }
__device__ __forceinline__ unsigned char* karg_ws(kptr_t kp) { return (unsigned char*)(*(__attribute__((address_space(1))) unsigned char* const __attribute__((address_space(4)))*)(kp + 232)); }

enum { I_X = 0, I_C, I_T5, I_MODW, I_MODB, I_N1G, I_N2G, I_FFIN, I_CONVW, I_CONVB, I_FFOUT, I_EVIN, I_EVOUT, I_DLAM, I_SUBLN, I_RELB, I_ODIN, I_ODOUT, I_LRE, I_LIM, I_LSTEP, I_BRE, I_BIM, I_CRE, I_CIM, I_S5D, I_GLU, I_FING };

__device__ __forceinline__ unsigned cvtpk(float lo, float hi) { unsigned r; asm volatile("v_cvt_pk_bf16_f32 %0, %1, %2" : "=v"(r) : "v"(lo), "v"(hi)); return r; }
__device__ __forceinline__ float bf_lo(unsigned w) { return __uint_as_float(w << 16); }
__device__ __forceinline__ float bf_hi(unsigned w) { return __uint_as_float(w & 0xffff0000u); }
__device__ __forceinline__ float bf1(bf16_t v) { return __uint_as_float(((unsigned)v) << 16); }
__device__ __forceinline__ float wave_sum(float v) {
#pragma unroll
    for (int o = 1; o < 64; o <<= 1) v += __shfl_xor(v, o);
    return v;
}
__device__ __forceinline__ float half_sum(float v) {
#pragma unroll
    for (int o = 1; o < 32; o <<= 1) v += __shfl_xor(v, o);
    return v;
}
__device__ __forceinline__ float swap32f(float v) { return __shfl_xor(v, 32); }
__device__ __forceinline__ int crow(int r, int hi) { return (r & 3) + 8 * (r >> 2) + 4 * hi; }
#define LDSW() asm volatile("s_waitcnt lgkmcnt(0)" ::: "memory")
#define VMW() asm volatile("s_waitcnt vmcnt(0)" ::: "memory")
__device__ __forceinline__ void bar_sync() { asm volatile("s_waitcnt vmcnt(0) lgkmcnt(0)" ::: "memory"); __builtin_amdgcn_s_barrier(); asm volatile("" ::: "memory"); }
__device__ __forceinline__ float sigmoidf_(float x) { return __builtin_amdgcn_rcpf(1.0f + __builtin_amdgcn_exp2f(-1.4426950408889634f * x)); }
__device__ __forceinline__ float gelu_t(float x) { const float u = 0.7978845608028654f * (x + 0.044715f * x * x * x); return x * __builtin_amdgcn_rcpf(1.0f + __builtin_amdgcn_exp2f(-2.8853900817779268f * u)); }

__device__ __forceinline__ void sincos_d(double x, double& s, double& c) {
    const double n = __builtin_rint(x * 0.63661977236758134308);
    double r = __builtin_fma(-n, 1.57079632673412561417e+00, x);
    r = __builtin_fma(-n, 6.07710050630396597660e-11, r);
    r = __builtin_fma(-n, 2.02226624879595063154e-21, r);
    const double z = r * r;
    double ps = -1.0 / 1307674368000.0;
    ps = __builtin_fma(ps, z, 1.0 / 6227020800.0);
    ps = __builtin_fma(ps, z, -1.0 / 39916800.0);
    ps = __builtin_fma(ps, z, 1.0 / 362880.0);
    ps = __builtin_fma(ps, z, -1.0 / 5040.0);
    ps = __builtin_fma(ps, z, 1.0 / 120.0);
    ps = __builtin_fma(ps, z, -1.0 / 6.0);
    const double sr = __builtin_fma(ps * z, r, r);
    double pc = 1.0 / 20922789888000.0;
    pc = __builtin_fma(pc, z, -1.0 / 87178291200.0);
    pc = __builtin_fma(pc, z, 1.0 / 479001600.0);
    pc = __builtin_fma(pc, z, -1.0 / 3628800.0);
    pc = __builtin_fma(pc, z, 1.0 / 40320.0);
    pc = __builtin_fma(pc, z, -1.0 / 720.0);
    pc = __builtin_fma(pc, z, 1.0 / 24.0);
    pc = __builtin_fma(pc, z, -0.5);
    const double cr = __builtin_fma(pc, z, 1.0);
    const int q = ((int)(long long)n) & 3;
    s = (q == 0) ? sr : (q == 1) ? cr : (q == 2) ? -sr : -cr;
    c = (q == 0) ? cr : (q == 1) ? -sr : (q == 2) ? -cr : sr;
}

__device__ __forceinline__ int dst_row(int n, int N, int mode) {
    if (mode == 1) { if (n < 512) { const int j = n & 63; return (n & ~63) + ((j < 32) ? 2 * j : 2 * (j - 32) + 1); } return n; }
    if (mode == 2) { const int half = N >> 1, bj = n / half, rem = n - bj * half; return 256 * (rem >> 7) + 128 * bj + (rem & 127); }
    return n;
}
__device__ __forceinline__ void transpose_item(const float* W, int K, int N, bf16_t* WT, int mode, LAS float* scr, int item, int lane) {
    const int nblk = N / 32, kb = item / nblk, nb = item % nblk, k0 = 64 * kb, n0 = 32 * nb;
#pragma unroll 8
    for (int i = 0; i < 32; ++i) { const int kk = 2 * i + (lane >> 5); scr[kk * 33 + (lane & 31)] = W[(size_t)(k0 + kk) * N + n0 + (lane & 31)]; }
    LDSW();
    const int c = lane & 7;
#pragma unroll
    for (int j = 0; j < 4; ++j) { const int n = (lane >> 3) + 8 * j; const LAS float* s = scr + (8 * c) * 33 + n;
        u32x4 o; o.x = cvtpk(s[0 * 33], s[1 * 33]); o.y = cvtpk(s[2 * 33], s[3 * 33]); o.z = cvtpk(s[4 * 33], s[5 * 33]); o.w = cvtpk(s[6 * 33], s[7 * 33]);
        *(u32x4*)(WT + (size_t)dst_row(n0 + n, N, mode) * K + k0 + 8 * c) = o; }
    LDSW();
}
__device__ __forceinline__ void phase_p0a(kptr_t kp0, LAS unsigned char* lds, int vcu, int G) { const kptr_t kp = klaunder(kp0);
    const int tid = tid_opaque(), lane = tid & 63, wid = tid >> 6;
    unsigned char* ws = karg_ws(kp);
    LAS float* scr = (LAS float*)(lds + wid * 16384);
    const int gw = vcu * NW + wid, NGW = G * NW;
    constexpr int I0 = 16 * 96, I1 = 16 * 32, I2 = 16 * 64, I3 = 16 * 32, I4 = 8 * 32, I5 = 16 * 176, I6 = 44 * 32;
    constexpr int NIT = I0 + I1 + I2 + I3 + I4 + 2 * I5 + 2 * I6;
#pragma unroll 1
    for (int it = gw; it < NIT; it += NGW) {
        int r = it; const float* W; bf16_t* WT; int K, N, mode = 0;
        if (r < I0) { W = karg_in(kp, I_EVIN); WT = (bf16_t*)(ws + WS_WEVIN); K = 1024; N = 3072; }
        else if ((r -= I0) < I1) { W = karg_in(kp, I_EVOUT); WT = (bf16_t*)(ws + WS_WEVOUT); K = 1024; N = 1024; }
        else if ((r -= I1) < I2) { W = karg_in(kp, I_ODIN); WT = (bf16_t*)(ws + WS_WODIN); K = 1024; N = 2048; mode = 1; }
        else if ((r -= I2) < I3) { W = karg_in(kp, I_ODOUT); WT = (bf16_t*)(ws + WS_WODOUT); K = 1024; N = 1024; }
        else if ((r -= I3) < I4) { W = karg_in(kp, I_GLU); WT = (bf16_t*)(ws + WS_WGLU); K = 512; N = 1024; mode = 2; }
        else if ((r -= I4) < 2 * I5) { const int l = r / I5; r -= l * I5; W = karg_in(kp, I_FFIN) + (size_t)l * 1024 * 5632; WT = (bf16_t*)(ws + WS_WFFIN + l * WFFIN_STRIDE); K = 1024; N = 5632; mode = 2; }
        else { r -= 2 * I5; const int l = r / I6; r -= l * I6; W = karg_in(kp, I_FFOUT) + (size_t)l * 2816 * 1024; WT = (bf16_t*)(ws + WS_WFFOUT + l * WFFOUT_STRIDE); K = 2816; N = 1024; }
        transpose_item(W, K, N, WT, mode, scr, r, lane);
    }
    for (int b = vcu; b < 256; b += G) {
        const int kb = b >> 3, cg = b & 7;
        float accv[3] = {0.f, 0.f, 0.f};
        for (int kk = 0; kk < 32; ++kk) { const int k = kb * 32 + kk; const float cv = karg_in(kp, I_C)[k]; const float cond = cv * sigmoidf_(cv);
#pragma unroll
            for (int j = 0; j < 3; ++j) { const int cidx = cg * 1536 + tid + 512 * j, ly = cidx / 6144, n = cidx - ly * 6144; accv[j] += cond * karg_in(kp, I_MODW)[((size_t)ly * 1024 + k) * 6144 + n]; } }
#pragma unroll
        for (int j = 0; j < 3; ++j) ((float*)(ws + WS_MODP))[(size_t)kb * 12288 + cg * 1536 + tid + 512 * j] = accv[j];
    }
    const int gid = vcu * 512 + tid, GN = G * 512;
    for (int e = gid; e < 2048; e += GN) { const int g = e >> 6;
        const double step = exp((double)karg_in(kp, I_LSTEP)[g]); const double lre = karg_in(kp, I_LRE)[e], lim = karg_in(kp, I_LIM)[e];
        const double mag = exp(lre * step); double sn, cs; sincos_d(lim * step, sn, cs);
        const double dar = mag * cs, dai = mag * sn, nr = dar - 1.0, ni = dai, den = lre * lre + lim * lim;
        ((f32x4*)(ws + WS_S5P))[e] = (f32x4){(float)dar, (float)dai, (float)((nr * lre + ni * lim) / den), (float)((ni * lre - nr * lim) / den)};
        const double mag2 = exp(lre * step * 256.0); sincos_d(lim * step * 256.0, sn, cs);
        ((f32x2*)(ws + WS_S5A))[e] = (f32x2){(float)(mag2 * cs), (float)(mag2 * sn)}; }
    for (int e = gid; e < L * 32; e += GN) { const int pos = e >> 5, i = e & 31;
        const float pf = (float)exp2(13.287712379549449 * (double)i / 32.0);
        const float inv = 1.0f / pf; const float ang = (float)pos * inv;
        double s, c; sincos_d((double)ang, s, c);
        ((f32x2*)(ws + WS_ROPE))[e] = (f32x2){(float)c, (float)s}; }
}
__device__ __forceinline__ void phase_p0b(kptr_t kp0, int vcu, int G) { const kptr_t kp = klaunder(kp0);
    const int gid = vcu * 512 + tid_opaque(), GN = G * 512;
    const float* mp = (const float*)(karg_ws(kp) + WS_MODP);
    for (int c = gid; c < 12288; c += GN) { float s = karg_in(kp, I_MODB)[c];
        for (int kb = 0; kb < 32; ++kb) s += mp[(size_t)kb * 12288 + c];
        ((float*)(karg_ws(kp) + WS_MOD))[c] = s; }
}
__device__ __forceinline__ void phase_p0c(kptr_t kp0, int vcu, int G) { const kptr_t kp = klaunder(kp0);
    const int tid = tid_opaque(), lane = tid & 63, wid = tid >> 6;
    const int gid = vcu * 512 + tid, GN = G * 512, gw = vcu * NW + wid, NGW = G * NW;
    const float* mod = (const float*)(karg_ws(kp) + WS_MOD);
    float* gm = (float*)(karg_ws(kp) + WS_GM);
    for (int i = gid; i < 4096; i += GN) { const int v = i >> 10, k = i & 1023, ly = v >> 1, second = v & 1;
        const float g = (second ? karg_in(kp, I_N2G) : karg_in(kp, I_N1G))[ly * 1024 + k]; const float sc = mod[ly * 6144 + (second ? 4096 : 1024) + k];
        gm[i] = g * (1.0f + sc); }
    f32x4 gv[4];
#pragma unroll
    for (int j = 0; j < 4; ++j) { const int k = 4 * lane + 256 * j; const f32x4 g = *(const f32x4*)(karg_in(kp, I_N1G) + k), sc = *(const f32x4*)(mod + 1024 + k); gv[j] = g * (sc + 1.0f); }
    bf16_t* AP = (bf16_t*)(karg_ws(kp) + WS_AP); float* rowss = (float*)(karg_ws(kp) + WS_ROWSS);
    for (int m = gw; m < L; m += NGW) {
        const f32x4* xr = (const f32x4*)(karg_in(kp, I_X) + (size_t)m * 1024) + lane; float s = 0.f; f32x4 v[4];
#pragma unroll
        for (int j = 0; j < 4; ++j) { v[j] = xr[64 * j]; s += (v[j][0] * v[j][0] + v[j][1] * v[j][1]) + (v[j][2] * v[j][2] + v[j][3] * v[j][3]); }
        s = wave_sum(s);
        u32x2* o8 = (u32x2*)(AP + (size_t)m * 1024) + lane;
#pragma unroll
        for (int j = 0; j < 4; ++j) { const f32x4 t = v[j] * gv[j]; o8[64 * j] = (u32x2){cvtpk(t[0], t[1]), cvtpk(t[2], t[3])}; }
        if (lane < 16) rowss[(size_t)m * 16 + lane] = (lane == 0) ? s : 0.f;
    }
    float* bvec = (float*)(karg_ws(kp) + WS_BV);
    for (int r = gw; r < 16384; r += NGW) {
        const bf16_t* wrow; const float* sh;
        if (r < 3072) { wrow = (const bf16_t*)(karg_ws(kp) + WS_WEVIN) + (size_t)r * 1024; sh = mod; }
        else if (r < 5120) { wrow = (const bf16_t*)(karg_ws(kp) + WS_WODIN) + (size_t)(r - 3072) * 1024; sh = mod + 6144; }
        else if (r < 10752) { wrow = (const bf16_t*)(karg_ws(kp) + WS_WFFIN) + (size_t)(r - 5120) * 1024; sh = mod + 3072; }
        else { wrow = (const bf16_t*)(karg_ws(kp) + WS_WFFIN + WFFIN_STRIDE) + (size_t)(r - 10752) * 1024; sh = mod + 6144 + 3072; }
        float s = 0.f;
#pragma unroll
        for (int j = 0; j < 2; ++j) { const int k = 8 * lane + 512 * j; const u32x4 w = *(const u32x4*)(wrow + k); const f32x4 s0 = *(const f32x4*)(sh + k), s1 = *(const f32x4*)(sh + k + 4);
            s += bf_lo(w.x) * s0[0] + bf_hi(w.x) * s0[1] + bf_lo(w.y) * s0[2] + bf_hi(w.y) * s0[3] + bf_lo(w.z) * s1[0] + bf_hi(w.z) * s1[1] + bf_lo(w.w) * s1[2] + bf_hi(w.w) * s1[3]; }
        s = wave_sum(s);
        if (lane == 0) bvec[r] = s;
    }
}
constexpr int AT_STG = 32768;
constexpr int AT_BIAS = 65536, AT_WSF = 65536 + 1024, AT_POST = 0;
constexpr float AT_THR = 8.0f;
__device__ __forceinline__ bf16x8 tr_frag(const LAS unsigned char* p) {
    const s16x4 lo = __builtin_bit_cast(s16x4, __builtin_amdgcn_ds_read_tr16_b64_v4i16((LAS v4i16_t*)p));
    const s16x4 hi = __builtin_bit_cast(s16x4, __builtin_amdgcn_ds_read_tr16_b64_v4i16((LAS v4i16_t*)(p + 512)));
    return (bf16x8){lo[0], lo[1], lo[2], lo[3], hi[0], hi[1], hi[2], hi[3]};
}
__device__ __forceinline__ bf16x8 pack8(const f32x16& p, int b) {
    u32x4 w; w.x = cvtpk(p[b], p[b + 1]); w.y = cvtpk(p[b + 2], p[b + 3]); w.z = cvtpk(p[b + 4], p[b + 5]); w.w = cvtpk(p[b + 6], p[b + 7]);
    return __builtin_bit_cast(bf16x8, w);
}
#define MFMA32(a, b, c) __builtin_amdgcn_mfma_f32_32x32x16_bf16(a, b, c, 0, 0, 0)

template <int DV, bool DIFF>
__device__ __forceinline__ void attn_unit(LAS unsigned char* lds, const bf16_t* proj, bf16_t* cat, int h, int q0, int T0, int T1,
                                          int qcol, int kcol, int vcol, int ocol, float lam, const float* subg, float lam_init) {
    constexpr int ND = DV / 32, NV = DV / 64, VOFF = DIFF ? 16384 : 8192;
    const int tid = tid_opaque(), lane = tid & 63, r32 = lane & 31, hi = lane >> 5; const int wid = __builtin_amdgcn_readfirstlane(tid >> 6);
    const int wq = DIFF ? (wid & 3) : wid, sub = DIFF ? (wid >> 2) : 0;
    const int rowbase = q0 + 32 * wq, cw = rowbase >> 6;
    const int tlo = DIFF ? 0 : (cw - 8), thi = cw;
    LAS float* btab = (LAS float*)(lds + AT_BIAS);
    LAS float* wsf = (LAS float*)(lds + AT_WSF) + wid * 64;
    bf16x8 qr[4];
    { const bf16_t* Qw = proj + (size_t)(rowbase + r32) * EV_IN + qcol + sub * 64 + hi * 8;
#pragma unroll
      for (int d0 = 0; d0 < 4; ++d0) qr[d0] = *(const bf16x8*)(Qw + d0 * 16); }
    const bf16_t* ksrc = proj + (size_t)lane * EV_IN + kcol + wid * 8;
    const bf16_t* vsrc = proj + (size_t)(16 * (wid & 3) + (lane >> 2)) * EV_IN + vcol + (wid >> 2) * 32 + (lane & 3) * 8;
    const int kdst = wid * 1024 + lane * 16, vdst = VOFF + (wid >> 2) * 4096 + (wid & 3) * 1024 + lane * 16;
    u32x4 sk0, sk1 = (u32x4){0u, 0u, 0u, 0u}, sv[NV];
#define AT_GLOAD(t_) do { const size_t ro_ = (size_t)(t_) * 64 * EV_IN; sk0 = *(const u32x4*)(ksrc + ro_); if (DIFF) sk1 = *(const u32x4*)(ksrc + ro_ + 64); \
        _Pragma("unroll") for (int j_ = 0; j_ < NV; ++j_) sv[j_] = *(const u32x4*)(vsrc + ro_ + j_ * 64); } while (0)
#define AT_LSTORE(s_) do { LAS unsigned char* st_ = lds + (s_) * AT_STG; *(LAS u32x4*)(st_ + kdst) = sk0; if (DIFF) *(LAS u32x4*)(st_ + 8192 + kdst) = sk1; \
        _Pragma("unroll") for (int j_ = 0; j_ < NV; ++j_) *(LAS u32x4*)(st_ + vdst + j_ * 8192) = sv[j_]; } while (0)
    float mref = -1e30f, lsum = 0.f;
    f32x16 o[ND];
#pragma unroll
    for (int d = 0; d < ND; ++d) o[d] = (f32x16){};
    const int kfo = (DIFF ? sub * 8192 : 0) + hi * 1024 + r32 * 16;
    const int vfo = VOFF + ((lane >> 4) & 1) * 32 + (lane & 3) * 8 + (4 * hi + ((lane & 15) >> 2)) * 64;
    AT_GLOAD(T0); AT_LSTORE(0); bar_sync();
    for (int t = T0; t <= T1; ++t) {
        const int s = (t - T0) & 1;
        if (t < T1) AT_GLOAD(t + 1);
        if (t >= tlo && t <= thi) {
            const LAS unsigned char* st = lds + s * AT_STG;
            f32x16 p0 = (f32x16){}, p1 = (f32x16){};
#pragma unroll
            for (int d0 = 0; d0 < 4; ++d0) {
                const bf16x8 b0 = *(const LAS bf16x8*)(st + kfo + d0 * 2048), b1 = *(const LAS bf16x8*)(st + kfo + d0 * 2048 + 512);
                p0 = MFMA32(b0, qr[d0], p0); p1 = MFMA32(b1, qr[d0], p1); }
            if (t >= cw - 2) {
                const int ib = 64 * t - (rowbase + r32) + 191 + 4 * hi;
#pragma unroll
                for (int r = 0; r < 16; ++r) { const int kv = (r & 3) + 8 * (r >> 2); p0[r] += btab[ib + kv]; p1[r] += btab[ib + kv + 32]; }
            }
            float rm = p0[0];
#pragma unroll
            for (int r = 1; r < 16; ++r) rm = fmaxf(rm, p0[r]);
#pragma unroll
            for (int r = 0; r < 16; ++r) rm = fmaxf(rm, p1[r]);
            rm = fmaxf(rm, swap32f(rm));
            if (__any(rm > mref + AT_THR)) {
                const float mnew = fmaxf(mref, rm), f = __builtin_amdgcn_exp2f(mref - mnew);
                mref = mnew; lsum *= f;
                if (hi == 0) wsf[r32] = f;
                LDSW();
#pragma unroll
                for (int r = 0; r < 16; ++r) { const float fr_ = wsf[crow(r, hi)];
#pragma unroll
                    for (int d = 0; d < ND; ++d) o[d][r] *= fr_; }
            }
            float sacc = 0.f;
#pragma unroll
            for (int r = 0; r < 16; ++r) { p0[r] = __builtin_amdgcn_exp2f(p0[r] - mref); p1[r] = __builtin_amdgcn_exp2f(p1[r] - mref); sacc += p0[r] + p1[r]; }
            lsum += sacc;
            const bf16x8 pw0 = pack8(p0, 0), pw1 = pack8(p0, 8), pw2 = pack8(p1, 0), pw3 = pack8(p1, 8);
#pragma unroll
            for (int d = 0; d < ND; ++d) {
                const LAS unsigned char* vp = st + vfo + d * 4096;
                o[d] = MFMA32(pw0, tr_frag(vp), o[d]); o[d] = MFMA32(pw1, tr_frag(vp + 1024), o[d]);
                o[d] = MFMA32(pw2, tr_frag(vp + 2048), o[d]); o[d] = MFMA32(pw3, tr_frag(vp + 3072), o[d]); }
        }
        if (t < T1) AT_LSTORE(s ^ 1);
        bar_sync();
    }
    lsum += swap32f(lsum);
    if (hi == 0) wsf[32 + r32] = 1.0f / lsum;
    LDSW();
#pragma unroll
    for (int r = 0; r < 16; ++r) { const float inv = wsf[32 + crow(r, hi)];
#pragma unroll
        for (int d = 0; d < ND; ++d) o[d][r] *= inv; }
    if (DIFF) {
        LAS float* xo = (LAS float*)(lds + AT_POST) + wq * 4096;
        if (sub == 1) {
#pragma unroll
            for (int r = 0; r < 16; ++r)
#pragma unroll
                for (int d = 0; d < ND; ++d) xo[crow(r, hi) * 128 + 32 * d + r32] = o[d][r];
        }
        bar_sync();
        LAS bf16_t* stg = (LAS bf16_t*)(lds + 65536 + 4096) + wq * 4096;
        if (sub == 0) {
            float gl[ND];
#pragma unroll
            for (int d = 0; d < ND; ++d) gl[d] = subg[32 * d + r32] * (1.0f - lam_init);
#pragma unroll
            for (int r = 0; r < 16; ++r) { float ss = 0.f;
#pragma unroll
                for (int d = 0; d < ND; ++d) { o[d][r] -= lam * xo[crow(r, hi) * 128 + 32 * d + r32]; ss += o[d][r] * o[d][r]; }
                ss = half_sum(ss);
                const float rs = 1.0f / sqrtf(ss * (1.0f / 128.0f) + EPS);
#pragma unroll
                for (int d = 0; d < ND; ++d) stg[crow(r, hi) * 128 + 32 * d + r32] = (bf16_t)(cvtpk(o[d][r] * rs * gl[d], 0.f) & 0xffffu); }
            LDSW();
#pragma unroll
            for (int i = 0; i < 8; ++i) { const int row = i * 4 + (lane >> 4), ch = lane & 15; const u32x4 v = *(const LAS u32x4*)(stg + row * 128 + ch * 8);
                *(u32x4*)(cat + (size_t)(rowbase + row) * 1024 + ocol + ch * 8) = v; }
        }
        bar_sync();
    } else {
        LAS bf16_t* stg = (LAS bf16_t*)(lds + AT_POST) + wid * 2048;
#pragma unroll
        for (int r = 0; r < 16; ++r)
#pragma unroll
            for (int d = 0; d < ND; ++d) stg[crow(r, hi) * 64 + 32 * d + r32] = (bf16_t)(cvtpk(o[d][r], 0.f) & 0xffffu);
        LDSW();
#pragma unroll
        for (int i = 0; i < 4; ++i) { const int row = i * 8 + (lane >> 3), ch = lane & 7; const u32x4 v = *(const LAS u32x4*)(stg + row * 64 + ch * 8);
            *(u32x4*)(cat + (size_t)(rowbase + row) * 1024 + ocol + ch * 8) = v; }
        bar_sync();
    }
}
__device__ __forceinline__ int t5_bucket(int rel) {
    const int n = rel < 0 ? -rel : rel; int b = rel > 0 ? 16 : 0;
    if (n < 8) return b + n;
    int lg = 31 - __builtin_clz((unsigned)((n * n) >> 6)); lg = 8 + lg; if (lg > 15) lg = 15;
    return b + lg;
}
__device__ __forceinline__ void phase_attn(kptr_t kp0, LAS unsigned char* lds, int vcu, int G) { const kptr_t kp = klaunder(kp0);
    const int tid = tid_opaque();
    const bf16_t* proj = (const bf16_t*)(karg_ws(kp) + WS_PROJ); bf16_t* cat = (bf16_t*)(karg_ws(kp) + WS_CAT);
    LAS float* btab = (LAS float*)(lds + AT_BIAS);
    const float lam_init = 0.2f;
    float d1 = 0.f, d2 = 0.f;
    for (int i = 0; i < 64; ++i) { d1 += karg_in(kp, I_DLAM)[i] * karg_in(kp, I_DLAM)[64 + i]; d2 += karg_in(kp, I_DLAM)[128 + i] * karg_in(kp, I_DLAM)[192 + i]; }
    const float lam = expf(d1) - expf(d2) + lam_init;
    for (int pu = vcu; pu < 256; pu += G) {
        const int h = pu >> 6, pr = pu & 63;
        if (tid < 255) { const int rel = tid - 191; btab[tid] = (karg_in(kp, I_T5)[t5_bucket(rel) * 4 + h] - karg_in(kp, I_T5)[15 * 4 + h]) * 1.4426950408889634f; }
        bar_sync();
        for (int k = 0; k < 2; ++k) { const int qb = k ? (127 - pr) : pr;
            attn_unit<128, true>(lds, proj, cat, h, 128 * qb, 0, 2 * qb + 1, h * 128, 512 + h * 128, 1024 + h * 128, h * 128, lam, karg_in(kp, I_SUBLN), lam_init); }
    }
    for (int bu = vcu; bu < 512; bu += G) {
        const int h = bu >> 6, blk = bu & 63;
        bar_sync();
        if (tid < 255) { int rel = tid - 191; if (rel < -128) rel = -128; btab[tid] = (karg_in(kp, I_RELB)[h * 257 + rel + 128] - karg_in(kp, I_RELB)[h * 257]) * 1.4426950408889634f; }
        bar_sync();
        const int T0 = (4 * blk - 8) < 0 ? 0 : (4 * blk - 8);
        attn_unit<64, false>(lds, proj, cat, h, 256 * blk, T0, 4 * blk + 3, 1536 + h * 64, 2048 + h * 64, 2560 + h * 64, 512 + h * 64, 0.f, nullptr, 0.f);
    }
}
#define MFMA16(a, b, c) __builtin_amdgcn_mfma_f32_16x16x32_bf16(a, b, c, 0, 0, 0)
__device__ __forceinline__ float ret_lg2(int h) { return h == 0 ? -0.04580368961312479f : h == 1 ? -0.02272007650008353f : h == 2 ? -0.011315313227834146f : -0.005646563141142063f; }
__device__ __forceinline__ u32x4 scale8(u32x4 w, float s) {
    u32x4 o; o.x = cvtpk(bf_lo(w.x) * s, bf_hi(w.x) * s); o.y = cvtpk(bf_lo(w.y) * s, bf_hi(w.y) * s); o.z = cvtpk(bf_lo(w.z) * s, bf_hi(w.z) * s); o.w = cvtpk(bf_lo(w.w) * s, bf_hi(w.w) * s); return o;
}
__device__ __forceinline__ void phase_ret1(kptr_t kp0, LAS unsigned char* lds, int vcu, int G) { const kptr_t kp = klaunder(kp0);
    const int tid = tid_opaque(), lane = tid & 63, r32 = lane & 31, hi = lane >> 5; const int wid = __builtin_amdgcn_readfirstlane(tid >> 6);
    const bf16_t* proj = (const bf16_t*)(karg_ws(kp) + WS_PROJ); float* retl = (float*)(karg_ws(kp) + WS_RETL);
    const int lanepat = ((lane >> 4) & 1) * 32 + (lane & 3) * 8 + (4 * hi + ((lane & 15) >> 2)) * 64;
    for (int item = vcu; item < 256; item += G) {
        const int h = item & 3, grp = item >> 2, R0 = 256 * grp; const float lg2 = ret_lg2(h);
#pragma unroll
        for (int i = 0; i < 4; ++i) { const int p = tid + 512 * i, j = p >> 3, c = p & 7;
            const u32x4 w = *(const u32x4*)(proj + (size_t)(R0 + j) * OD_IN + 256 + h * 64 + 8 * c);
            *(LAS u32x4*)(lds + (c >> 2) * 16384 + (j >> 4) * 1024 + (j & 15) * 64 + (c & 3) * 16) = scale8(w, __builtin_amdgcn_exp2f(lg2 * (float)(255 - j))); }
#pragma unroll
        for (int i = 0; i < 8; ++i) { const int p = tid + 512 * i, j = p >> 4, c = p & 15;
            const u32x4 w = *(const u32x4*)(proj + (size_t)(R0 + j) * OD_IN + 512 + h * 128 + 8 * c);
            *(LAS u32x4*)(lds + 32768 + (c >> 2) * 16384 + (j >> 4) * 1024 + (j & 15) * 64 + (c & 3) * 16) = w; }
        bar_sync();
        const int db = wid >> 2, eb = wid & 3;
        f32x16 acc = (f32x16){};
#pragma unroll 4
        for (int ks = 0; ks < 16; ++ks) acc = MFMA32(tr_frag(lds + db * 16384 + ks * 1024 + lanepat), tr_frag(lds + 32768 + eb * 16384 + ks * 1024 + lanepat), acc);
        float* dst = retl + ((size_t)(grp * 4 + h) * 64 + 32 * db) * 128 + 32 * eb + r32;
#pragma unroll
        for (int r = 0; r < 16; ++r) dst[crow(r, hi) * 128] = acc[r];
        bar_sync();
    }
}
constexpr int RT_ST = 65536, RT_STB = 18432, RT_RS = 65536 + 2 * 18432;
__device__ __forceinline__ void phase_ret2(kptr_t kp0, LAS unsigned char* lds, int vcu, int G) { const kptr_t kp = klaunder(kp0);
    const int tid = tid_opaque(), lane = tid & 63, r32 = lane & 31, hi = lane >> 5; const int wid = __builtin_amdgcn_readfirstlane(tid >> 6);
    const bf16_t* proj = (const bf16_t*)(karg_ws(kp) + WS_PROJ); const float* retc = (const float*)(karg_ws(kp) + WS_RETC); bf16_t* cat = (bf16_t*)(karg_ws(kp) + WS_CAT);
    const int lanepat = ((lane >> 4) & 1) * 32 + (lane & 3) * 8 + (4 * hi + ((lane & 15) >> 2)) * 64;
    const int ib = wid >> 2, db = wid >> 2, eb = wid & 3;
    for (int item = vcu; item < 256; item += G) {
        const int h = item & 3, grp = item >> 2, R0 = 256 * grp; const float lg2 = ret_lg2(h); const float cd = __builtin_amdgcn_exp2f(lg2 * 64.0f);
        const bf16_t* kcs = proj + (size_t)(R0 + lane) * OD_IN + 256 + h * 64 + wid * 8;
        const int kcd = wid * 1024 + lane * 16;
        const int srow = 16 * (wid & 3) + (lane >> 2);
        const bf16_t* kds = proj + (size_t)(R0 + srow) * OD_IN + 256 + h * 64 + (wid >> 2) * 32 + (lane & 3) * 8;
        const int kdd = 8192 + (wid >> 2) * 4096 + (wid & 3) * 1024 + lane * 16;
        const bf16_t* vvs = proj + (size_t)(R0 + srow) * OD_IN + 512 + h * 128 + (wid >> 2) * 32 + (lane & 3) * 8;
        const int vvd = 16384 + (wid >> 2) * 4096 + (wid & 3) * 1024 + lane * 16;
        const float kdsc = __builtin_amdgcn_exp2f(lg2 * (float)(63 - srow));
        u32x4 s_kc, s_kd, s_v0, s_v1;
#define RT_GLOAD(c_) do { const size_t ro_ = (size_t)(c_) * 64 * OD_IN; s_kc = *(const u32x4*)(kcs + ro_); s_kd = *(const u32x4*)(kds + ro_); s_v0 = *(const u32x4*)(vvs + ro_); s_v1 = *(const u32x4*)(vvs + ro_ + 64); } while (0)
#define RT_LSTORE(s_) do { LAS unsigned char* st_ = lds + (s_) * 32768; *(LAS u32x4*)(st_ + kcd) = s_kc; *(LAS u32x4*)(st_ + kdd) = scale8(s_kd, kdsc); *(LAS u32x4*)(st_ + vvd) = s_v0; *(LAS u32x4*)(st_ + vvd + 8192) = s_v1; } while (0)
        f32x16 S;
        { const float* src = retc + ((size_t)(grp * 4 + h) * 64 + 32 * db) * 128 + 32 * eb + r32;
#pragma unroll
          for (int r = 0; r < 16; ++r) S[r] = src[crow(r, hi) * 128]; }
#define RT_STWRITE(sb_) do { LAS unsigned char* sp_ = lds + RT_ST + (sb_) * RT_STB + (32 * eb + r32) * 144 + (32 * db + 4 * hi) * 2; \
        _Pragma("unroll") for (int r4_ = 0; r4_ < 4; ++r4_) *(LAS u32x2*)(sp_ + r4_ * 16) = (u32x2){cvtpk(S[4 * r4_], S[4 * r4_ + 1]), cvtpk(S[4 * r4_ + 2], S[4 * r4_ + 3])}; } while (0)
        RT_STWRITE(0);
        RT_GLOAD(0); RT_LSTORE(0);
        bar_sync();
#pragma unroll 1
        for (int c = 0; c < 4; ++c) {
            const int s = c & 1, Rc = R0 + 64 * c;
            if (c < 3) RT_GLOAD(c + 1);
            const LAS unsigned char* st = lds + s * 32768;
            bf16x8 qr[4];
            { const bf16_t* Qw = proj + (size_t)(Rc + 32 * ib + r32) * OD_IN + h * 64 + hi * 8;
#pragma unroll
              for (int d0 = 0; d0 < 4; ++d0) qr[d0] = *(const bf16x8*)(Qw + d0 * 16); }
            f32x16 p0 = (f32x16){}, p1 = (f32x16){};
            const int kfo = hi * 1024 + r32 * 16;
#pragma unroll
            for (int d0 = 0; d0 < 4; ++d0) {
                const bf16x8 b0 = *(const LAS bf16x8*)(st + kfo + d0 * 2048), b1 = *(const LAS bf16x8*)(st + kfo + d0 * 2048 + 512);
                p0 = MFMA32(b0, qr[d0], p0); p1 = MFMA32(b1, qr[d0], p1); }
            int iloc = 32 * ib + r32; asm volatile("" : "+v"(iloc));
            int hio = hi; asm volatile("" : "+v"(hio));
#pragma unroll
            for (int r = 0; r < 16; ++r) { const int j = crow(r, hio); int d0_ = iloc - j; d0_ = d0_ < 0 ? -d0_ : d0_; int d1_ = iloc - j - 32; d1_ = d1_ < 0 ? -d1_ : d1_;
                p0[r] *= __builtin_amdgcn_exp2f(lg2 * (float)d0_); p1[r] *= __builtin_amdgcn_exp2f(lg2 * (float)d1_); }
            const bf16x8 pw0 = pack8(p0, 0), pw1 = pack8(p0, 8), pw2 = pack8(p1, 0), pw3 = pack8(p1, 8);
            const LAS unsigned char* vp = st + 16384 + eb * 4096 + lanepat;
            f32x16 o = (f32x16){};
            o = MFMA32(pw0, tr_frag(vp), o); o = MFMA32(pw1, tr_frag(vp + 1024), o); o = MFMA32(pw2, tr_frag(vp + 2048), o); o = MFMA32(pw3, tr_frag(vp + 3072), o);
            f32x16 cx = (f32x16){};
            { const LAS unsigned char* sp = lds + RT_ST + s * RT_STB + (32 * eb + r32) * 144 + hi * 16;
#pragma unroll
              for (int d0 = 0; d0 < 4; ++d0) cx = MFMA32(qr[d0], *(const LAS bf16x8*)(sp + d0 * 32), cx); }
            LAS float* rsb = (LAS float*)(lds + RT_RS);
#pragma unroll
            for (int r = 0; r < 16; ++r) { const int i = 32 * ib + crow(r, hio); o[r] += __builtin_amdgcn_exp2f(lg2 * (float)(i + 1)) * cx[r];
                const float ss = half_sum(o[r] * o[r]); if (r32 == 0) rsb[i * 4 + eb] = ss; }
            { const LAS unsigned char* kp = st + 8192 + db * 4096 + lanepat; f32x16 kv = (f32x16){};
#pragma unroll
              for (int ks = 0; ks < 4; ++ks) kv = MFMA32(tr_frag(kp + ks * 1024), tr_frag(vp + ks * 1024), kv);
#pragma unroll
              for (int r = 0; r < 16; ++r) S[r] = cd * S[r] + kv[r]; }
            bar_sync();
#pragma unroll
            for (int r = 0; r < 16; ++r) { const int i = 32 * ib + crow(r, hi); const f32x4 q4 = *(const LAS f32x4*)(rsb + i * 4);
                const float rs = 1.0f / sqrtf(((q4[0] + q4[1]) + (q4[2] + q4[3])) * (1.0f / 128.0f) + EPS);
                const float g = bf1(proj[(size_t)(Rc + i) * OD_IN + 1024 + h * 128 + 32 * eb + r32]);
                cat[(size_t)(Rc + i) * 1024 + h * 128 + 32 * eb + r32] = (bf16_t)(cvtpk(o[r] * rs * g * sigmoidf_(g), 0.f) & 0xffffu); }
            RT_STWRITE(s ^ 1);
            if (c < 3) RT_LSTORE(s ^ 1);
            bar_sync();
        }
    }
#undef RT_GLOAD
#undef RT_LSTORE
#undef RT_STWRITE
}
template <bool PASS2>
__device__ __forceinline__ void phase_s5(kptr_t kp0, LAS unsigned char* lds, int vcu, int G) { const kptr_t kp = klaunder(kp0);
    const int tid = tid_opaque(), lane = tid & 63; const int wid = __builtin_amdgcn_readfirstlane(tid >> 6);
    const int gw = vcu * NW + wid, NGW = G * NW;
    const bf16_t* proj = (const bf16_t*)(karg_ws(kp) + WS_PROJ); bf16_t* yg = (bf16_t*)(karg_ws(kp) + WS_YG);
    LAS float* ubuf = (LAS float*)(lds + wid * 6144);
    LAS bf16_t* xt = (LAS bf16_t*)(lds + wid * 6144 + 1024);
    for (int wi = gw; wi < 2048; wi += NGW) {
        const int g = wi & 31, seg = wi >> 5, t0 = seg * 256, n = lane;
        float ar, ai, bbr[16], bbi[16];
        { const f32x4 prm = ((const f32x4*)(karg_ws(kp) + WS_S5P))[g * 64 + n]; ar = prm[0]; ai = prm[1]; const float cr = prm[2], ci = prm[3];
          const f32x4* br = (const f32x4*)(karg_in(kp, I_BRE) + ((size_t)g * 64 + n) * 16); const f32x4* bi = (const f32x4*)(karg_in(kp, I_BIM) + ((size_t)g * 64 + n) * 16);
#pragma unroll
          for (int q = 0; q < 4; ++q) { const f32x4 vr = br[q], vi = bi[q];
#pragma unroll
              for (int j = 0; j < 4; ++j) { bbr[4 * q + j] = cr * vr[j] - ci * vi[j]; bbi[4 * q + j] = cr * vi[j] + ci * vr[j]; } } }
        float xr = 0.f, xi = 0.f;
        bf16x8 cfr[4]; float dsk = 0.f;
        if (PASS2) {
            const f32x2 c0 = ((const f32x2*)(karg_ws(kp) + WS_S5C))[((size_t)g * 64 + seg) * 64 + n]; xr = c0[0]; xi = c0[1];
            const int p = lane & 15, kq = lane >> 4;
#pragma unroll
            for (int s = 0; s < 4; ++s) { const float* src = ((s < 2) ? karg_in(kp, I_CRE) : karg_in(kp, I_CIM)) + ((size_t)g * 16 + p) * 64 + 32 * (s & 1) + 8 * kq; const float sg = (s < 2) ? 1.0f : -1.0f;
                const f32x4 v0 = *(const f32x4*)src * sg, v1 = *(const f32x4*)(src + 4) * sg;
                u32x4 w; w.x = cvtpk(v0[0], v0[1]); w.y = cvtpk(v0[2], v0[3]); w.z = cvtpk(v1[0], v1[1]); w.w = cvtpk(v1[2], v1[3]); cfr[s] = __builtin_bit_cast(bf16x8, w); }
            dsk = karg_in(kp, I_S5D)[g * 16 + p];
        }
        const bf16_t* usrc = proj + (size_t)(t0 + (lane >> 2)) * OD_IN + 1536 + g * 16 + 4 * (lane & 3);
        u32x2 un = *(const u32x2*)usrc;
        for (int blk = 0; blk < 16; ++blk) {
            *(LAS f32x4*)(ubuf + (lane >> 2) * 16 + 4 * (lane & 3)) = (f32x4){bf_lo(un.x), bf_hi(un.x), bf_lo(un.y), bf_hi(un.y)};
            if (blk < 15) un = *(const u32x2*)(usrc + (size_t)(blk + 1) * 16 * OD_IN);
            LDSW();
#pragma unroll 4
            for (int tt = 0; tt < 16; ++tt) {
                const f32x4 u0 = *(const LAS f32x4*)(ubuf + tt * 16), u1 = *(const LAS f32x4*)(ubuf + tt * 16 + 4), u2 = *(const LAS f32x4*)(ubuf + tt * 16 + 8), u3 = *(const LAS f32x4*)(ubuf + tt * 16 + 12);
                float br_ = 0.f, bi_ = 0.f;
#pragma unroll
                for (int j = 0; j < 4; ++j) { br_ += bbr[j] * u0[j] + bbr[4 + j] * u1[j] + bbr[8 + j] * u2[j] + bbr[12 + j] * u3[j]; bi_ += bbi[j] * u0[j] + bbi[4 + j] * u1[j] + bbi[8 + j] * u2[j] + bbi[12 + j] * u3[j]; }
                const float nxr = ar * xr - ai * xi + br_, nxi = ar * xi + ai * xr + bi_;
                xr = nxr; xi = nxi;
                if (PASS2) { xt[tt * 136 + n] = (bf16_t)(cvtpk(xr, 0.f) & 0xffffu); xt[tt * 136 + 64 + n] = (bf16_t)(cvtpk(xi, 0.f) & 0xffffu); }
            }
            if (PASS2) {
                LDSW();
                f32x4 y = (f32x4){0.f, 0.f, 0.f, 0.f};
#pragma unroll
                for (int s = 0; s < 4; ++s) y = MFMA16(*(const LAS bf16x8*)(xt + (lane & 15) * 136 + 32 * s + 8 * (lane >> 4)), cfr[s], y);
                const int p = lane & 15;
#pragma unroll
                for (int i = 0; i < 4; ++i) { const int t = 4 * (lane >> 4) + i; const float v = y[i] + dsk * ubuf[t * 16 + p];
                    yg[(size_t)(t0 + blk * 16 + t) * 512 + g * 16 + p] = (bf16_t)(cvtpk(gelu_t(v), 0.f) & 0xffffu); }
            }
            LDSW();
        }
        if (!PASS2) ((f32x2*)(karg_ws(kp) + WS_S5L))[((size_t)g * 64 + seg) * 64 + n] = (f32x2){xr, xi};
    }
}
__device__ __forceinline__ void phase_scans(kptr_t kp0, int vcu, int G) { const kptr_t kp = klaunder(kp0);
    const int gid = vcu * 512 + tid_opaque(), GN = G * 512;
    for (int idx = gid; idx < 32768 + 2048; idx += GN) {
        if (idx < 32768) {
            const int h = idx >> 13, de = idx & 8191; const float cd4 = __builtin_amdgcn_exp2f(ret_lg2(h) * 256.0f);
            const float* src = (const float*)(karg_ws(kp) + WS_RETL) + (size_t)h * 8192 + de; float* dst = (float*)(karg_ws(kp) + WS_RETC) + (size_t)h * 8192 + de;
            float C = 0.f;
            for (int g0 = 0; g0 < 64; g0 += 8) { float e[8];
#pragma unroll
                for (int k = 0; k < 8; ++k) e[k] = src[(size_t)(g0 + k) * 32768];
#pragma unroll
                for (int k = 0; k < 8; ++k) { dst[(size_t)(g0 + k) * 32768] = C; C = cd4 * C + e[k]; } }
        } else {
            const int i2 = idx - 32768, g = i2 >> 6, n = i2 & 63;
            const f32x2 A256 = ((const f32x2*)(karg_ws(kp) + WS_S5A))[i2]; const float Ar = A256[0], Ai = A256[1];
            const f32x2* src = (const f32x2*)(karg_ws(kp) + WS_S5L) + (size_t)g * 4096 + n; f32x2* dst = (f32x2*)(karg_ws(kp) + WS_S5C) + (size_t)g * 4096 + n;
            float cr = 0.f, ci = 0.f;
            for (int s0 = 0; s0 < 64; s0 += 8) { f32x2 e[8];
#pragma unroll
                for (int k = 0; k < 8; ++k) e[k] = src[(s0 + k) * 64];
#pragma unroll
                for (int k = 0; k < 8; ++k) { dst[(s0 + k) * 64] = (f32x2){cr, ci}; const float nr = Ar * cr - Ai * ci + e[k][0], ni = Ar * ci + Ai * cr + e[k][1]; cr = nr; ci = ni; } }
        }
    }
}
__device__ __forceinline__ void ffn_fixup(kptr_t kp0, int layer, int pm) { const kptr_t kp = klaunder(kp0);
    if (pm > 0) {
        const float* hv = (const float*)(karg_ws(kp) + WS_HEADV) + (size_t)pm * 2 * 2816; const float* hg = (const float*)(karg_ws(kp) + WS_HEADG) + (size_t)pm * 2 * 2816;
        const float* tg = (const float*)(karg_ws(kp) + WS_TAILG) + (size_t)(pm - 1) * 2 * 2816;
        const float* cw = karg_in(kp, I_CONVW) + (size_t)layer * 3 * 2816; const float* cb = karg_in(kp, I_CONVB) + (size_t)layer * 2816;
        bf16_t* act = (bf16_t*)(karg_ws(kp) + WS_PROJ) + (size_t)pm * 256 * 2816;
        for (int f = tid_opaque(); f < 2816; f += 512) {
            const float gm2 = tg[f], gm1 = tg[2816 + f], g0 = hg[f], g1 = hg[2816 + f], w0 = cw[f], w1 = cw[2816 + f], w2 = cw[5632 + f], b = cb[f];
            act[f] = (bf16_t)(cvtpk(gelu_t(w0 * gm2 + w1 * gm1 + w2 * g0 + b) * hv[f], 0.f) & 0xffffu);
            act[2816 + f] = (bf16_t)(cvtpk(gelu_t(w0 * gm1 + w1 * g0 + w2 * g1 + b) * hv[2816 + f], 0.f) & 0xffffu);
        }
    }
    asm volatile("s_waitcnt vmcnt(0)" ::: "memory");
    __builtin_amdgcn_fence(__ATOMIC_RELEASE, "agent");
    __builtin_amdgcn_fence(__ATOMIC_ACQUIRE, "agent");
    asm volatile("s_waitcnt vmcnt(0)" ::: "memory");
    __syncthreads();
}
__device__ __forceinline__ void phase_final(kptr_t kp0, int vcu, int G) { const kptr_t kp = klaunder(kp0);
    const int tid_ = tid_opaque(), lane = tid_ & 63, wid = tid_ >> 6, gw = vcu * NW + wid, NGW = G * NW;
    const float* rowss = (const float*)(karg_ws(kp) + WS_ROWSS) + (size_t)4 * L * 16;
    f32x4 gv[4];
#pragma unroll
    for (int j = 0; j < 4; ++j) gv[j] = *(const f32x4*)(karg_in(kp, I_FING) + 4 * lane + 256 * j);
    for (int m = gw; m < L; m += NGW) {
        const float rs = 1.0f / sqrtf(wave_sum(lane < 16 ? rowss[(size_t)m * 16 + lane] : 0.f) * (1.0f / 1024.0f) + EPS);
        f32x4* xr = (f32x4*)(karg_out(kp) + (size_t)m * 1024) + lane;
#pragma unroll
        for (int j = 0; j < 4; ++j) xr[64 * j] = xr[64 * j] * rs * gv[j];
    }
}
#ifdef NO_G_PROJ
#define EN_PROJ 0
#else
#define EN_PROJ 1
#endif
#ifdef NO_G_RES1
#define EN_RES1 0
#else
#define EN_RES1 1
#endif
#ifdef NO_G_ROPE
#define EN_ROPE 0
#else
#define EN_ROPE 1
#endif
#ifdef NO_G_GLU
#define EN_GLU 0
#else
#define EN_GLU 1
#endif
#ifdef NO_G_RES2
#define EN_RES2 0
#else
#define EN_RES2 1
#endif
#ifdef NO_G_FFN
#define EN_FFN 0
#else
#define EN_FFN 1
#endif
#ifdef NO_G_RES3
#define EN_RES3 0
#else
#define EN_RES3 1
#endif
#ifdef NO_GSYNC
#define GSYNC() __syncthreads()
#else
#define GSYNC() do { asm volatile("s_waitcnt vmcnt(0) lgkmcnt(0)" ::: "memory"); grid.sync(); __builtin_amdgcn_fence(__ATOMIC_ACQUIRE, "agent"); asm volatile("s_waitcnt vmcnt(0)" ::: "memory"); } while (0)
#endif
#ifndef STOP_AFTER
#define STOP_AFTER 0
#endif
__global__ void __launch_bounds__(512, 2) mega_fwd(Args a_unused) {
#define kp (kargs_fresh())
    extern __shared__ __attribute__((aligned(16))) unsigned char lds_raw[];
    LAS unsigned char* lds = (LAS unsigned char*)lds_raw;
    cg::grid_group grid = cg::this_grid();
    const int G = gridDim.x, bx = blockIdx.x, vcu = (G % 8 == 0) ? (bx % 8) * (G / 8) + bx / 8 : bx;
#define ws (karg_ws(kargs_fresh()))
#define mod ((const float*)(ws + WS_MOD))
#define gmv ((const float*)(ws + WS_GM))
#define bvec ((const float*)(ws + WS_BV))
#define rowss ((float*)(ws + WS_ROWSS))
#define AP ((bf16_t*)(ws + WS_AP))
#define PROJ ((bf16_t*)(ws + WS_PROJ))
#define CAT ((bf16_t*)(ws + WS_CAT))
#ifdef NO_GEMM
#define GEMM_PHASE(EPI, Aptr, Bptr, N_, K_, E_) do {} while (0)
#else
#define GEMM_PHASE(EPI, Aptr, Bptr, N_, K_, E_) do { int gG_ = G, gbx_ = bx; asm volatile("" : "+s"(gG_), "+s"(gbx_));     \
        pg8::Gemm g_{(const pg8::bf16_t*)(Aptr), (const pg8::bf16_t*)(Bptr), L, (N_), (K_)}; pg8::StaticOrder S_; S_.init(L, (N_), gG_, gbx_); \
        pg8::gemm_phase<EPI, pg8::StaticOrder, true, true>(lds, g_, S_, E_); } while (0)
#endif

#ifndef NO_P0
    phase_p0a(kargs_fresh(), lds, vcu, G); GSYNC();
    phase_p0b(kargs_fresh(), vcu, G); GSYNC();
    phase_p0c(kargs_fresh(), vcu, G); GSYNC();
#endif
#ifdef DUMP_WS_BF16
    { const int gid_ = vcu * 512 + tid_opaque(); for (size_t i = gid_; i < (size_t)L * 1024; i += (size_t)G * 512) karg_out(kp)[i] = bf1(((const bf16_t*)(ws + (size_t)(DUMP_WS_BF16)))[i % (size_t)(DUMP_N)]); return; }
#endif
#ifdef DUMP_WS_F32
    { const int gid_ = vcu * 512 + tid_opaque(); for (size_t i = gid_; i < (size_t)L * 1024; i += (size_t)G * 512) karg_out(kp)[i] = ((const float*)(ws + (size_t)(DUMP_WS_F32)))[i % (size_t)(DUMP_N)]; return; }
#endif
#define modl (mod + layer * 6144)
    {
        constexpr int layer = 0;
            { pg8::EpiProj E{PROJ, EV_IN, bvec, rowss, 0xC3u}; if (EN_PROJ) GEMM_PHASE(pg8::EpiProj, AP, ws + WS_WEVIN, EV_IN, 1024, E); }
            GSYNC();
#ifndef NO_ATTN
            phase_attn(kargs_fresh(), lds, vcu, G);
#endif
            GSYNC();
#ifdef DUMP_CAT
            { const int gid_ = vcu * 512 + tid_opaque(); for (size_t i = gid_; i < (size_t)L * 1024; i += (size_t)G * 512) karg_out(kp)[i] = bf1(CAT[i]); return; }
#endif
#ifdef DUMP_PROJ
            { const int gid_ = vcu * 512 + tid_opaque(); for (size_t i = gid_; i < (size_t)L * 1024; i += (size_t)G * 512) { const size_t r = i >> 10, c = i & 1023; karg_out(kp)[i] = bf1(PROJ[r * 3072 + (DUMP_PROJ) * 1024 + c]); } return; }
#endif
            { pg8::EpiRes E{karg_in(kp, I_X), karg_out(kp), modl + 2048, gmv + 1024, AP, rowss + (size_t)L * 16}; if (EN_RES1) GEMM_PHASE(pg8::EpiRes, CAT, ws + WS_WEVOUT, 1024, 1024, E); }
            GSYNC();
#ifdef DUP_EVOUT_1
            { pg8::EpiRes E{karg_in(kp, I_X), karg_out(kp), mod + 2048, gmv + 1024, AP, rowss + (size_t)L * 16}; GEMM_PHASE(pg8::EpiRes, CAT, ws + WS_WEVOUT, 1024, 1024, E); }
            GSYNC();
#endif
#if STOP_AFTER == 1
            return;
#endif
        { pg8::EpiFfn E{PROJ, bvec + 5120 + layer * 5632, rowss + (size_t)(layer ? 3 : 1) * L * 16, karg_in(kp, I_CONVW) + (size_t)layer * 3 * 2816, karg_in(kp, I_CONVB) + (size_t)layer * 2816,
                        (float*)(ws + WS_HEADV), (float*)(ws + WS_HEADG), (float*)(ws + WS_TAILG), (LAS float*)(lds + LDS_XG)};
          if (EN_FFN) GEMM_PHASE(pg8::EpiFfn, AP, ws + WS_WFFIN + layer * WFFIN_STRIDE, 5632, 1024, E); }
        GSYNC();
#ifdef DUP_EVOUT_FFNIN
        { pg8::EpiRes E{karg_in(kp, I_X), karg_out(kp), mod + 2048, gmv + 1024, AP, rowss + (size_t)L * 16}; GEMM_PHASE(pg8::EpiRes, CAT, ws + WS_WEVOUT, 1024, 1024, E); }
        GSYNC();
        return;
#endif
        { pg8::StaticOrder S0; S0.init(L, 1024, G, bx); pg8::Unit u0; for (int i = 0; S0.next(i, u0); ++i) ffn_fixup(kargs_fresh(), layer, u0.pm);
          pg8::EpiRes E{karg_out(kp), karg_out(kp), modl + 5120, layer ? nullptr : gmv + 2048, AP, rowss + (size_t)(layer ? 4 : 2) * L * 16}; if (EN_RES3) GEMM_PHASE(pg8::EpiRes, PROJ, ws + WS_WFFOUT + layer * WFFOUT_STRIDE, 1024, 2816, E); }
        GSYNC();
#if STOP_AFTER == 2
        if (layer == 0) {
#ifdef PRE_SYNCS
            for (int q = 0; q < PRE_SYNCS; ++q) GSYNC();
#endif
#ifdef DUP_AFTER_FFNOUT
            { pg8::EpiRes E{karg_in(kp, I_X), karg_out(kp), mod + 2048, gmv + 1024, AP, rowss + (size_t)L * 16}; GEMM_PHASE(pg8::EpiRes, CAT, ws + WS_WEVOUT, 1024, 1024, E); }
            GSYNC();
#endif
#ifdef EXTRA_SYNCS
            for (int q = 0; q < EXTRA_SYNCS; ++q) GSYNC();
#endif
#ifdef END_DUMP_BF16
            { const int gid_ = vcu * 512 + tid_opaque(); for (size_t i = gid_; i < (size_t)L * 1024; i += (size_t)G * 512) karg_out(kp)[i] = bf1(((const bf16_t*)(ws + (size_t)(END_DUMP_BF16)))[i % (size_t)(DUMP_N)]); }
#endif
#ifdef END_DUMP_F32
            { const int gid_ = vcu * 512 + tid_opaque(); for (size_t i = gid_; i < (size_t)L * 1024; i += (size_t)G * 512) karg_out(kp)[i] = ((const float*)(ws + (size_t)(END_DUMP_F32)))[i % (size_t)(DUMP_N)]; }
#endif
            return; }
#endif
    }
    {
        constexpr int layer = 1;
            { pg8::EpiRope E{PROJ, OD_IN, bvec + 3072, rowss + (size_t)2 * L * 16, (const float*)(ws + WS_ROPE)}; if (EN_ROPE) GEMM_PHASE(pg8::EpiRope, AP, ws + WS_WODIN, OD_IN, 1024, E); }
            GSYNC();
#if !defined(NO_RET) && !defined(NO_RET1)
            phase_ret1(kargs_fresh(), lds, vcu, G);
#endif
#ifndef NO_S5
            phase_s5<false>(kargs_fresh(), lds, vcu, G);
#endif
            GSYNC();
#ifndef NO_SCAN
            phase_scans(kargs_fresh(), vcu, G);
#endif
            GSYNC();
#if !defined(NO_RET) && !defined(NO_RET2)
            phase_ret2(kargs_fresh(), lds, vcu, G);
#endif
#ifndef NO_S5
            phase_s5<true>(kargs_fresh(), lds, vcu, G);
#endif
            GSYNC();
            { pg8::EpiGlu E{CAT, 1024, 512}; if (EN_GLU) GEMM_PHASE(pg8::EpiGlu, ws + WS_YG, ws + WS_WGLU, 1024, 512, E); }
            GSYNC();
            { pg8::EpiRes E{karg_out(kp), karg_out(kp), modl + 2048, gmv + 3072, AP, rowss + (size_t)3 * L * 16}; if (EN_RES2) GEMM_PHASE(pg8::EpiRes, CAT, ws + WS_WODOUT, 1024, 1024, E); }
            GSYNC();
#if STOP_AFTER == 3
            return;
#endif
        { pg8::EpiFfn E{PROJ, bvec + 5120 + layer * 5632, rowss + (size_t)(layer ? 3 : 1) * L * 16, karg_in(kp, I_CONVW) + (size_t)layer * 3 * 2816, karg_in(kp, I_CONVB) + (size_t)layer * 2816,
                        (float*)(ws + WS_HEADV), (float*)(ws + WS_HEADG), (float*)(ws + WS_TAILG), (LAS float*)(lds + LDS_XG)};
          if (EN_FFN) GEMM_PHASE(pg8::EpiFfn, AP, ws + WS_WFFIN + layer * WFFIN_STRIDE, 5632, 1024, E); }
        GSYNC();
#ifdef DUP_EVOUT_FFNIN
        { pg8::EpiRes E{karg_in(kp, I_X), karg_out(kp), mod + 2048, gmv + 1024, AP, rowss + (size_t)L * 16}; GEMM_PHASE(pg8::EpiRes, CAT, ws + WS_WEVOUT, 1024, 1024, E); }
        GSYNC();
        return;
#endif
        { pg8::StaticOrder S0; S0.init(L, 1024, G, bx); pg8::Unit u0; for (int i = 0; S0.next(i, u0); ++i) ffn_fixup(kargs_fresh(), layer, u0.pm);
          pg8::EpiRes E{karg_out(kp), karg_out(kp), modl + 5120, layer ? nullptr : gmv + 2048, AP, rowss + (size_t)(layer ? 4 : 2) * L * 16}; if (EN_RES3) GEMM_PHASE(pg8::EpiRes, PROJ, ws + WS_WFFOUT + layer * WFFOUT_STRIDE, 1024, 2816, E); }
        GSYNC();
#if STOP_AFTER == 2
        if (layer == 0) {
#ifdef PRE_SYNCS
            for (int q = 0; q < PRE_SYNCS; ++q) GSYNC();
#endif
#ifdef DUP_AFTER_FFNOUT
            { pg8::EpiRes E{karg_in(kp, I_X), karg_out(kp), mod + 2048, gmv + 1024, AP, rowss + (size_t)L * 16}; GEMM_PHASE(pg8::EpiRes, CAT, ws + WS_WEVOUT, 1024, 1024, E); }
            GSYNC();
#endif
#ifdef EXTRA_SYNCS
            for (int q = 0; q < EXTRA_SYNCS; ++q) GSYNC();
#endif
#ifdef END_DUMP_BF16
            { const int gid_ = vcu * 512 + tid_opaque(); for (size_t i = gid_; i < (size_t)L * 1024; i += (size_t)G * 512) karg_out(kp)[i] = bf1(((const bf16_t*)(ws + (size_t)(END_DUMP_BF16)))[i % (size_t)(DUMP_N)]); }
#endif
#ifdef END_DUMP_F32
            { const int gid_ = vcu * 512 + tid_opaque(); for (size_t i = gid_; i < (size_t)L * 1024; i += (size_t)G * 512) karg_out(kp)[i] = ((const float*)(ws + (size_t)(END_DUMP_F32)))[i % (size_t)(DUMP_N)]; }
#endif
            return; }
#endif
    }
    phase_final(kargs_fresh(), vcu, G);
#undef ws
#undef mod
#undef gmv
#undef bvec
#undef rowss
#undef AP
#undef PROJ
#undef CAT
#undef modl
#undef kp
}
extern "C" void kernel_launch(void* const* d_in, const int* in_sizes, int n_in, void* d_out, int out_size, void* d_ws, size_t ws_size, hipStream_t stream) {
    static int grid = 0;
    if (grid == 0) {
        if (n_in != 28 || out_size != L * DM || ws_size < WS_END) { fprintf(stderr, "kernel_launch: unexpected problem (n_in %d out %d ws %zu)\n", n_in, out_size, ws_size); grid = -1; return; }
        int dev = 0, cus = 0, per_cu = 0;
        hipGetDevice(&dev); hipDeviceGetAttribute(&cus, hipDeviceAttributeMultiprocessorCount, dev);
        hipFuncSetAttribute((const void*)mega_fwd, hipFuncAttributeMaxDynamicSharedMemorySize, LDS_BYTES);
        hipOccupancyMaxActiveBlocksPerMultiprocessor(&per_cu, (const void*)mega_fwd, 512, LDS_BYTES);
        (void)hipGetLastError();
        if (per_cu < 1) { fprintf(stderr, "kernel_launch: occupancy query says %d blocks per CU\n", per_cu); per_cu = 1; }
        grid = cus;
    }
    if (grid < 0) return;
    Args a{};
    for (int i = 0; i < 28; ++i) a.in[i] = (const float*)d_in[i];
    a.out = (float*)d_out; a.ws = (unsigned char*)d_ws;
    void* args[] = {&a};
    hipError_t e = hipLaunchCooperativeKernel((void*)mega_fwd, dim3(grid), dim3(512), args, LDS_BYTES, stream);
    if (e != hipSuccess) fprintf(stderr, "cooperative launch failed: %s (grid %d)\n", hipGetErrorString(e), grid);
}
```

```cpp
#include <hip/hip_runtime.h>
#include <hip/hip_cooperative_groups.h>
#include <cstdio>
#include <cstdint>
namespace cg = cooperative_groups;
__device__ __forceinline__ int tid_opaque() { int t = threadIdx.x; asm volatile("" : "+v"(t)); return t; }
namespace pg8 {
#define PG8_LAS __attribute__((address_space(3)))
typedef unsigned short bf16_t;
typedef short bf16x8 __attribute__((ext_vector_type(8)));
typedef float f32x4 __attribute__((ext_vector_type(4)));
typedef unsigned u32x4 __attribute__((ext_vector_type(4)));
constexpr int BM = 256, BK = 64, HALF = 128, HTB = HALF * BK * 2  , STAGE_BYTES = 8 * HTB, NXCD = 8, WGM = 8;

__host__ __device__ __forceinline__ int lds_byte(int r, int c) { const int st = (r >> 4) * 2 + (c >> 5), rr = r & 15, cc = c & 31, ob = rr * 64 + cc * 2; return st * 1024 + (ob ^ (((ob >> 9) & 1) << 5)); }
__host__ __device__ __forceinline__ void stage_rc(int b, int& R, int& C) { const int st = b / 1024, sb = b % 1024, swz = sb ^ (((sb >> 9) & 1) << 5); R = (st >> 1) * 16 + swz / 64; C = (st & 1) * 32 + (swz % 64) / 2; }
__host__ __device__ __forceinline__ int perm32(int rho) { const int n = rho >> 4, i = rho & 15; return 8 * (i >> 2) + 4 * n + (i & 3); }

struct Unit { int pm, pn; };
struct Gemm { const bf16_t* A; const bf16_t* Bt; int M, N, K; };

struct StaticOrder {
    int nM, nN, nwg, G, c;
    __host__ __device__ __forceinline__ void init(int M, int N, int G_, int c_) { nM = M / BM; nN = N / BM; nwg = nM * nN; G = G_; c = c_; }
    __host__ __device__ __forceinline__ bool next(int i, Unit& u) const {
        const long L = (long)i * G + c; if (L >= nwg) return false;
        int wgid = (int)L; { const int q = nwg / NXCD, r = nwg % NXCD, xcd = wgid % NXCD, off = wgid / NXCD; wgid = (xcd < r ? xcd * (q + 1) : r * (q + 1) + (xcd - r) * q) + off; }
        const int nig = WGM * nN, gid = wgid / nig, fm = gid * WGM, gsz = (nM - fm) < WGM ? (nM - fm) : WGM;
        u.pm = fm + ((wgid % nig) % gsz); u.pn = (wgid % nig) / gsz; return true;
    }
    __device__ __forceinline__ void a_ready(const Unit&) const {}
    __device__ __forceinline__ void done(const Unit&) const {}
};

__device__ __forceinline__ unsigned cvt_pk_bf16(float lo, float hi) { unsigned r; asm volatile("v_cvt_pk_bf16_f32 %0, %1, %2" : "=v"(r) : "v"(lo), "v"(hi)); return r; }
typedef float f32x2 __attribute__((ext_vector_type(2)));
constexpr float RMS_EPS = 1e-6f;
constexpr float C2Q = 0.125f * 1.4426950408889634f;
typedef unsigned u32x2 __attribute__((ext_vector_type(2)));
__device__ __forceinline__ float fast_sigmoid(float x) { return __builtin_amdgcn_rcpf(1.0f + __builtin_amdgcn_exp2f(-1.4426950408889634f * x)); }
__device__ __forceinline__ float gelu_tanh(float x) { const float u = 0.7978845608028654f * (x + 0.044715f * x * x * x); return x * __builtin_amdgcn_rcpf(1.0f + __builtin_amdgcn_exp2f(-2.8853900817779268f * u)); }
__device__ __forceinline__ float rs_of(const float* p16, int fq) { const f32x4 a = *(const f32x4*)(p16 + 4 * fq);
    float ss = (a[0] + a[1]) + (a[2] + a[3]); ss += __shfl_xor(ss, 16); ss += __shfl_xor(ss, 32);
    return 1.0f / sqrtf(ss * (1.0f / 1024.0f) + RMS_EPS); }
struct EpiProj {
    static constexpr bool PERM = true, AFTER_DRAIN = false;
    bf16_t* O; int ldc; const float* bv; const float* rowss; unsigned qmask;
    __device__ __forceinline__ void operator()(const f32x4 (&acc)[2][2][4][2], const Unit& u, int wr, int wc, int fr, int fq) const {
        const int row0 = u.pm * BM + wr * 64 + fr, col0 = u.pn * BM + wc * 32 + 8 * fq;
        const float sc = ((qmask >> u.pn) & 1u) ? C2Q : 1.0f;
        f32x4 bvv[2][2];
#pragma unroll
        for (int bj = 0; bj < 2; ++bj)
#pragma unroll
            for (int n = 0; n < 2; ++n) bvv[bj][n] = *(const f32x4*)(bv + col0 + bj * HALF + 4 * n);
#pragma unroll
        for (int ai = 0; ai < 2; ++ai)
#pragma unroll
            for (int m = 0; m < 4; ++m) { const int row = row0 + ai * HALF + m * 16; const float rs = rs_of(rowss + (size_t)row * 16, fq); bf16_t* rowp = O + (size_t)row * ldc + col0;
#pragma unroll
                for (int bj = 0; bj < 2; ++bj) { const f32x4 v0 = (acc[ai][bj][m][0] * rs + bvv[bj][0]) * sc, v1 = (acc[ai][bj][m][1] * rs + bvv[bj][1]) * sc;
                    u32x4 w; w.x = cvt_pk_bf16(v0[0], v0[1]); w.y = cvt_pk_bf16(v0[2], v0[3]); w.z = cvt_pk_bf16(v1[0], v1[1]); w.w = cvt_pk_bf16(v1[2], v1[3]);
                    *(u32x4*)(rowp + bj * HALF) = w; } }
    }
};
struct EpiRope {
    static constexpr bool PERM = true, AFTER_DRAIN = false;
    bf16_t* O; int ldc; const float* bv; const float* rowss; const float* rope;
    __device__ __forceinline__ void operator()(const f32x4 (&acc)[2][2][4][2], const Unit& u, int wr, int wc, int fr, int fq) const {
        const int row0 = u.pm * BM + wr * 64 + fr, col0 = u.pn * BM + wc * 32 + 8 * fq;
        const bool rot = u.pn < 2; const float sc = (u.pn == 1) ? 0.125f : 1.0f;
        const int i0 = 16 * (wc & 1) + 4 * fq;
        f32x4 bvv[2][2];
#pragma unroll
        for (int bj = 0; bj < 2; ++bj)
#pragma unroll
            for (int n = 0; n < 2; ++n) bvv[bj][n] = *(const f32x4*)(bv + col0 + bj * HALF + 4 * n);
#pragma unroll
        for (int ai = 0; ai < 2; ++ai)
#pragma unroll
            for (int m = 0; m < 4; ++m) { const int row = row0 + ai * HALF + m * 16; const float rs = rs_of(rowss + (size_t)row * 16, fq); bf16_t* rowp = O + (size_t)row * ldc + col0;
                f32x4 cs0 = (f32x4){1.f, 0.f, 1.f, 0.f}, cs1 = cs0;
                if (rot) { const f32x4* rp = (const f32x4*)(rope + ((size_t)row * 32 + i0) * 2); cs0 = rp[0]; cs1 = rp[1]; }
#pragma unroll
                for (int bj = 0; bj < 2; ++bj) { f32x4 v0 = acc[ai][bj][m][0] * rs + bvv[bj][0], v1 = acc[ai][bj][m][1] * rs + bvv[bj][1];
                    if (rot) {
                        f32x4 r0, r1;
                        r0[0] = v0[0] * cs0[0] - v0[1] * cs0[1]; r0[1] = v0[0] * cs0[1] + v0[1] * cs0[0];
                        r0[2] = v0[2] * cs0[2] - v0[3] * cs0[3]; r0[3] = v0[2] * cs0[3] + v0[3] * cs0[2];
                        r1[0] = v1[0] * cs1[0] - v1[1] * cs1[1]; r1[1] = v1[0] * cs1[1] + v1[1] * cs1[0];
                        r1[2] = v1[2] * cs1[2] - v1[3] * cs1[3]; r1[3] = v1[2] * cs1[3] + v1[3] * cs1[2];
                        v0 = r0 * sc; v1 = r1 * sc; }
                    u32x4 w; w.x = cvt_pk_bf16(v0[0], v0[1]); w.y = cvt_pk_bf16(v0[2], v0[3]); w.z = cvt_pk_bf16(v1[0], v1[1]); w.w = cvt_pk_bf16(v1[2], v1[3]);
                    *(u32x4*)(rowp + bj * HALF) = w; } }
    }
};
struct EpiRes {
    static constexpr bool PERM = true, AFTER_DRAIN = false;
    const float* xin; float* xout; const float* gate; const float* gm; bf16_t* AP; float* rowss;
    __device__ __forceinline__ void operator()(const f32x4 (&acc)[2][2][4][2], const Unit& u, int wr, int wc, int fr, int fq) const {
        const int row0 = u.pm * BM + wr * 64 + fr, col0 = u.pn * BM + wc * 32 + 8 * fq;
        f32x4 gv[2][2], gmv[2][2];
#pragma unroll
        for (int bj = 0; bj < 2; ++bj)
#pragma unroll
            for (int n = 0; n < 2; ++n) { gv[bj][n] = *(const f32x4*)(gate + col0 + bj * HALF + 4 * n); gmv[bj][n] = gm ? *(const f32x4*)(gm + col0 + bj * HALF + 4 * n) : (f32x4){0.f, 0.f, 0.f, 0.f}; }
#pragma unroll
        for (int ai = 0; ai < 2; ++ai)
#pragma unroll
            for (int m = 0; m < 4; ++m) { const int row = row0 + ai * HALF + m * 16; const size_t off = (size_t)row * 1024 + col0; float ss = 0.f;
#pragma unroll
                for (int bj = 0; bj < 2; ++bj) {
                    const f32x4 x0 = *(const f32x4*)(xin + off + bj * HALF) + gv[bj][0] * acc[ai][bj][m][0];
                    const f32x4 x1 = *(const f32x4*)(xin + off + bj * HALF + 4) + gv[bj][1] * acc[ai][bj][m][1];
                    *(f32x4*)(xout + off + bj * HALF) = x0; *(f32x4*)(xout + off + bj * HALF + 4) = x1;
                    ss += (x0[0] * x0[0] + x0[1] * x0[1]) + (x0[2] * x0[2] + x0[3] * x0[3]) + (x1[0] * x1[0] + x1[1] * x1[1]) + (x1[2] * x1[2] + x1[3] * x1[3]);
                    if (gm) { const f32x4 a0 = x0 * gmv[bj][0], a1 = x1 * gmv[bj][1];
                        u32x4 w; w.x = cvt_pk_bf16(a0[0], a0[1]); w.y = cvt_pk_bf16(a0[2], a0[3]); w.z = cvt_pk_bf16(a1[0], a1[1]); w.w = cvt_pk_bf16(a1[2], a1[3]);
                        *(u32x4*)(AP + off + bj * HALF) = w; } }
                ss += __shfl_xor(ss, 16); ss += __shfl_xor(ss, 32);
                if (fq == 0) rowss[(size_t)row * 16 + u.pn * 4 + wc] = ss; }
    }
};
struct EpiGlu {
    static constexpr bool PERM = true, AFTER_DRAIN = false;
    bf16_t* O; int ldc; int ocol0;
    __device__ __forceinline__ void operator()(const f32x4 (&acc)[2][2][4][2], const Unit& u, int wr, int wc, int fr, int fq) const {
        const int row0 = u.pm * BM + wr * 64 + fr, col0 = ocol0 + u.pn * HALF + wc * 32 + 8 * fq;
#pragma unroll
        for (int ai = 0; ai < 2; ++ai)
#pragma unroll
            for (int m = 0; m < 4; ++m) { const int row = row0 + ai * HALF + m * 16;
                f32x4 y0, y1;
#pragma unroll
                for (int j = 0; j < 4; ++j) { y0[j] = acc[ai][0][m][0][j] * fast_sigmoid(acc[ai][1][m][0][j]); y1[j] = acc[ai][0][m][1][j] * fast_sigmoid(acc[ai][1][m][1][j]); }
                u32x4 w; w.x = cvt_pk_bf16(y0[0], y0[1]); w.y = cvt_pk_bf16(y0[2], y0[3]); w.z = cvt_pk_bf16(y1[0], y1[1]); w.w = cvt_pk_bf16(y1[2], y1[3]);
                *(u32x4*)(O + (size_t)row * ldc + col0) = w; }
    }
};
struct EpiFfn {
    static constexpr bool PERM = true, AFTER_DRAIN = false;
    bf16_t* ACT; const float* bv; const float* rowss; const float* cw; const float* cb; float* headv; float* headg; float* tailg; PG8_LAS float* xg;
    __device__ __forceinline__ void operator()(const f32x4 (&acc)[2][2][4][2], const Unit& u, int wr, int wc, int fr, int fq) const {
        const int lane = (fq << 4) | fr;
        const int lc = wc * 32 + 8 * fq, f0 = u.pn * HALF + lc, pc0 = u.pn * BM + lc;
        float rs[2][4];
#pragma unroll
        for (int ai = 0; ai < 2; ++ai)
#pragma unroll
            for (int m = 0; m < 4; ++m) rs[ai][m] = rs_of(rowss + (size_t)(u.pm * BM + ai * HALF + wr * 64 + m * 16 + fr) * 16, fq);
        if (fr >= 14) {
#pragma unroll
            for (int n = 0; n < 2; ++n) { const f32x4 bvg = *(const f32x4*)(bv + pc0 + HALF + 4 * n);
#pragma unroll
                for (int ai = 0; ai < 2; ++ai) { const f32x4 g3 = acc[ai][1][3][n] * rs[ai][3] + bvg;
                    *(PG8_LAS f32x4*)(xg + ((2 * ai + wr) * 2 + (fr - 14)) * 128 + lc + 4 * n) = g3;
                    if (ai == 1 && wr == 1) *(f32x4*)(tailg + (size_t)(u.pm * 2 + (fr - 14)) * 2816 + f0 + 4 * n) = g3; } }
        }
        asm volatile("s_waitcnt lgkmcnt(0)" ::: "memory"); __builtin_amdgcn_s_barrier(); asm volatile("" ::: "memory");
        const int src1 = (lane & 48) | ((fr + 15) & 15), src2 = (lane & 48) | ((fr + 14) & 15);
        u32x2 pk0[2][4];
#pragma unroll
        for (int n = 0; n < 2; ++n) {
            const f32x4 w0 = *(const f32x4*)(cw + f0 + 4 * n), w1 = *(const f32x4*)(cw + 2816 + f0 + 4 * n), w2 = *(const f32x4*)(cw + 5632 + f0 + 4 * n), cbv = *(const f32x4*)(cb + f0 + 4 * n);
            const f32x4 bvv = *(const f32x4*)(bv + pc0 + 4 * n), bvg = *(const f32x4*)(bv + pc0 + HALF + 4 * n);
#pragma unroll
            for (int ai = 0; ai < 2; ++ai) {
                const int b = 2 * ai + wr;
                f32x4 P1 = (f32x4){0.f, 0.f, 0.f, 0.f}, P2 = P1;
                if (b >= 1) { P2 = *(const PG8_LAS f32x4*)(xg + ((b - 1) * 2 + 0) * 128 + lc + 4 * n); P1 = *(const PG8_LAS f32x4*)(xg + ((b - 1) * 2 + 1) * 128 + lc + 4 * n); }
                f32x4 s1p = P1, s2p = (fr == 1) ? P1 : P2;
#pragma unroll
                for (int m = 0; m < 4; ++m) {
                    const int row = u.pm * BM + ai * HALF + wr * 64 + m * 16 + fr;
                    const bool head = (b == 0) && (m == 0) && (fr < 2) && (u.pm > 0);
                    const f32x4 g = acc[ai][1][m][n] * rs[ai][m] + bvg;
                    const f32x4 val = acc[ai][0][m][n] * rs[ai][m] + bvv;
                    f32x4 s1, s2;
#pragma unroll
                    for (int j = 0; j < 4; ++j) { s1[j] = __shfl(g[j], src1); s2[j] = __shfl(g[j], src2); }
                    const f32x4 p1 = (fr >= 1) ? s1 : s1p, p2 = (fr >= 2) ? s2 : s2p;
                    s1p = s1; s2p = s2;
                    const f32x4 cv = w0 * p2 + w1 * p1 + w2 * g + cbv;
                    f32x4 av;
#pragma unroll
                    for (int j = 0; j < 4; ++j) av[j] = gelu_tanh(cv[j]) * val[j];
                    if (head) { *(f32x4*)(headv + (size_t)(u.pm * 2 + fr) * 2816 + f0 + 4 * n) = val; *(f32x4*)(headg + (size_t)(u.pm * 2 + fr) * 2816 + f0 + 4 * n) = g; }
                    const u32x2 pk = (u32x2){cvt_pk_bf16(av[0], av[1]), cvt_pk_bf16(av[2], av[3])};
                    if (n == 0) pk0[ai][m] = pk;
                    else if (!head) { u32x4 w; w.x = pk0[ai][m].x; w.y = pk0[ai][m].y; w.z = pk.x; w.w = pk.y; *(u32x4*)(ACT + (size_t)row * 2816 + f0) = w; }
                }
            }
        }
    }
};
template <class Epi, class Sched, bool ALIGN_EPI = false, bool SP2 = false>
__device__ __forceinline__ void gemm_phase(PG8_LAS unsigned char* lds, const Gemm g, const Sched& S, const Epi& E) {
    const int tid = tid_opaque(), wid = __builtin_amdgcn_readfirstlane(tid >> 6), lane = tid & 63, wr = wid >> 2, wc = wid & 3, fr = lane & 15, fq = lane >> 4;
    const int K = g.K, nt = K / BK;
    unsigned voffA[2], voffB[2];
#pragma unroll
    for (int i = 0; i < 2; ++i) { int R, C; stage_rc(tid * 16 + i * 8192, R, C); const int Rb = Epi::PERM ? ((R & ~31) + perm32(R & 31)) : R;
        voffA[i] = (unsigned)(R * K + C) * 2u; voffB[i] = (unsigned)(Rb * K + C) * 2u; }
    const size_t kstep = (size_t)(BK * 2);
    const size_t hstep = (size_t)HALF * K * 2;
    const size_t tstep = 2 * hstep;
    const unsigned ldsw = (unsigned)wid * 1024u;
    const int aoff = lds_byte(wr * 64 + fr, fq * 8), boff = lds_byte(wc * 32 + fr, fq * 8);
#define PG8_SA(b, h) (((b) * 2 + (h)) * HTB)
#define PG8_SB(b, h) ((4 + (b) * 2 + (h)) * HTB)
#define PG8_STAGE(bufoff, gbase, voff) do { _Pragma("unroll") for (int _i = 0; _i < 2; ++_i) { unsigned _vo = (voff)[_i]; asm volatile("" : "+v"(_vo)); \
        __builtin_amdgcn_global_load_lds((const unsigned*)((const char*)(gbase) + _vo), (PG8_LAS unsigned*)(lds + (bufoff) + ldsw + _i * 8192), 16, 0, 0); } } while (0)
#define PG8_LDA(dst, b, h) do { _Pragma("unroll") for (int m = 0; m < 4; ++m) _Pragma("unroll") for (int k = 0; k < 2; ++k) dst[m][k] = *(const PG8_LAS bf16x8*)(lds + PG8_SA(b, h) + aoff + m * 2048 + k * 1024); } while (0)
#define PG8_LDB(dst, b, h) do { _Pragma("unroll") for (int n = 0; n < 2; ++n) _Pragma("unroll") for (int k = 0; k < 2; ++k) dst[n][k] = *(const PG8_LAS bf16x8*)(lds + PG8_SB(b, h) + boff + n * 2048 + k * 1024); } while (0)
#define PG8_MMA(ai, bj, At, Bt) do { __builtin_amdgcn_s_setprio(1); _Pragma("unroll") for (int m = 0; m < 4; ++m) _Pragma("unroll") for (int n = 0; n < 2; ++n) _Pragma("unroll") for (int k = 0; k < 2; ++k) \
        acc[ai][bj][m][n] = __builtin_amdgcn_mfma_f32_16x16x32_bf16(Bt[n][k], At[m][k], acc[ai][bj][m][n], 0, 0, 0); __builtin_amdgcn_s_setprio(0); } while (0)
#define PG8_WAIT_V(n) asm volatile("s_waitcnt vmcnt(" #n ")" ::: "memory")
#define PG8_WAIT_L(n) asm volatile("s_waitcnt lgkmcnt(" #n ")" ::: "memory")
#define PG8_BAR do { asm volatile("" ::: "memory"); __builtin_amdgcn_s_barrier(); asm volatile("" ::: "memory"); } while (0)
#define PG8_SCHED __builtin_amdgcn_sched_barrier(0)
    Unit cur, nxt; int ui = 0;
    if (!S.next(0, cur)) return;
    f32x4 acc[2][2][4][2];
#pragma unroll
    for (int a = 0; a < 2; ++a)
#pragma unroll
        for (int b = 0; b < 2; ++b)
#pragma unroll
            for (int m = 0; m < 4; ++m)
#pragma unroll
                for (int n = 0; n < 2; ++n) acc[a][b][m][n] = (f32x4){0.f, 0.f, 0.f, 0.f};
    bf16x8 At[4][2], B0[2][2], B1[2][2];
    const char* cA = (const char*)g.A + (size_t)cur.pm * tstep; const char* cB = (const char*)g.Bt + (size_t)cur.pn * tstep;
    S.a_ready(cur);
    if constexpr (SP2) {
        PG8_STAGE(PG8_SB(0, 0), cB, voffB); PG8_STAGE(PG8_SB(0, 1), cB + hstep, voffB); PG8_STAGE(PG8_SA(0, 0), cA, voffA); PG8_STAGE(PG8_SA(0, 1), cA + hstep, voffA);
        if (wr == 1) PG8_BAR;
        PG8_WAIT_V(2); PG8_BAR;
        PG8_STAGE(PG8_SB(1, 0), cB + kstep, voffB); PG8_STAGE(PG8_SA(1, 0), cA + kstep, voffA); PG8_STAGE(PG8_SB(1, 1), cB + hstep + kstep, voffB);
        PG8_WAIT_V(6); PG8_BAR;
    } else {
        PG8_STAGE(PG8_SB(0, 0), cB, voffB); PG8_STAGE(PG8_SA(0, 0), cA, voffA); PG8_STAGE(PG8_SB(0, 1), cB + hstep, voffB); PG8_STAGE(PG8_SA(0, 1), cA + hstep, voffA);
        if (wr == 1) PG8_BAR;
        PG8_WAIT_V(4); PG8_BAR;
        PG8_STAGE(PG8_SB(1, 0), cB + kstep, voffB); PG8_STAGE(PG8_SA(1, 0), cA + kstep, voffA); PG8_STAGE(PG8_SB(1, 1), cB + hstep + kstep, voffB);
        PG8_WAIT_V(6); PG8_BAR;
    }
    for (;;) {
        const bool has_next = S.next(ui + 1, nxt);
        const char* nA = has_next ? (const char*)g.A + (size_t)nxt.pm * tstep : cA; const char* nB = has_next ? (const char*)g.Bt + (size_t)nxt.pn * tstep : cB;
        for (int t = 0; t < nt; t += 2) {
            const bool last = (t == nt - 2);
            const char* a1 = cA + (size_t)(t + 1) * kstep;
            const char* a2 = last ? nA : cA + (size_t)(t + 2) * kstep; const char* b2 = last ? nB : cB + (size_t)(t + 2) * kstep;
            const char* a3 = a2 + kstep; const char* b3 = b2 + kstep;
            if (last && has_next) S.a_ready(nxt);
            if constexpr (SP2) {
            PG8_LDB(B0, 0, 0); PG8_LDB(B1, 0, 1); PG8_SCHED; PG8_LDA(At, 0, 0); PG8_STAGE(PG8_SA(1, 1), a1 + hstep, voffA);
            PG8_WAIT_V(8); PG8_WAIT_L(0); PG8_BAR; PG8_MMA(0, 0, At, B0); PG8_MMA(0, 1, At, B1); PG8_BAR; PG8_SCHED;
            PG8_LDA(At, 0, 1); PG8_STAGE(PG8_SB(0, 0), b2, voffB); PG8_STAGE(PG8_SB(0, 1), b2 + hstep, voffB); PG8_STAGE(PG8_SA(0, 0), a2, voffA);
            PG8_WAIT_V(8); PG8_WAIT_L(0); PG8_BAR; PG8_MMA(1, 0, At, B0); PG8_MMA(1, 1, At, B1); PG8_BAR; PG8_SCHED;
            PG8_LDB(B0, 1, 0); PG8_LDB(B1, 1, 1); PG8_SCHED; PG8_LDA(At, 1, 0); PG8_STAGE(PG8_SA(0, 1), a2 + hstep, voffA);
            PG8_WAIT_V(8); PG8_WAIT_L(0); PG8_BAR; PG8_MMA(0, 0, At, B0); PG8_MMA(0, 1, At, B1); PG8_BAR; PG8_SCHED;
            PG8_LDA(At, 1, 1); PG8_STAGE(PG8_SB(1, 0), b3, voffB); PG8_STAGE(PG8_SB(1, 1), b3 + hstep, voffB); PG8_STAGE(PG8_SA(1, 0), a3, voffA);
            PG8_WAIT_V(8); PG8_WAIT_L(0); PG8_BAR; PG8_MMA(1, 0, At, B0); PG8_MMA(1, 1, At, B1); PG8_BAR; PG8_SCHED;
            } else {
            PG8_LDB(B0, 0, 0); PG8_SCHED; PG8_LDA(At, 0, 0); PG8_STAGE(PG8_SA(1, 1), a1 + hstep, voffA);
            PG8_WAIT_L(8); PG8_BAR; PG8_WAIT_L(0); PG8_MMA(0, 0, At, B0); PG8_BAR; PG8_SCHED;
            PG8_LDB(B1, 0, 1); PG8_STAGE(PG8_SB(0, 0), b2, voffB);
            PG8_BAR; PG8_WAIT_L(0); PG8_MMA(0, 1, At, B1); PG8_BAR;
            PG8_LDA(At, 0, 1); PG8_STAGE(PG8_SA(0, 0), a2, voffA);
            PG8_BAR; PG8_WAIT_L(0); PG8_MMA(1, 0, At, B0); PG8_BAR; PG8_SCHED;
            PG8_STAGE(PG8_SB(0, 1), b2 + hstep, voffB);
            PG8_WAIT_V(6); PG8_BAR; PG8_MMA(1, 1, At, B1); PG8_BAR;
            PG8_LDB(B0, 1, 0); PG8_SCHED; PG8_LDA(At, 1, 0); PG8_STAGE(PG8_SA(0, 1), a2 + hstep, voffA);
            PG8_WAIT_L(8); PG8_BAR; PG8_WAIT_L(0); PG8_MMA(0, 0, At, B0); PG8_BAR; PG8_SCHED;
            PG8_LDB(B1, 1, 1); PG8_STAGE(PG8_SB(1, 0), b3, voffB);
            PG8_BAR; PG8_WAIT_L(0); PG8_MMA(0, 1, At, B1); PG8_BAR;
            PG8_LDA(At, 1, 1); PG8_STAGE(PG8_SA(1, 0), a3, voffA);
            PG8_BAR; PG8_WAIT_L(0); PG8_MMA(1, 0, At, B0); PG8_BAR; PG8_SCHED;
            PG8_STAGE(PG8_SB(1, 1), b3 + hstep, voffB);
            PG8_WAIT_V(6); PG8_BAR; PG8_MMA(1, 1, At, B1); PG8_BAR;
            }
        }
        if constexpr (ALIGN_EPI) { if (wr == 0) PG8_BAR; }
        if constexpr (!Epi::AFTER_DRAIN) { E(acc, cur, wr, wc, fr, fq); S.done(cur); }
        if (!has_next) break;
#pragma unroll
        for (int a = 0; a < 2; ++a)
#pragma unroll
            for (int b = 0; b < 2; ++b)
#pragma unroll
                for (int m = 0; m < 4; ++m)
#pragma unroll
                    for (int n = 0; n < 2; ++n) acc[a][b][m][n] = (f32x4){0.f, 0.f, 0.f, 0.f};
        cur = nxt; cA = nA; cB = nB; ++ui;
        if constexpr (ALIGN_EPI) { if (wr == 1) PG8_BAR; }
    }
    PG8_WAIT_V(0);
    if constexpr (!ALIGN_EPI) { if (wr == 0) PG8_BAR; }
    PG8_BAR;
    if constexpr (Epi::AFTER_DRAIN) { E.fused(acc, cur, wr, wc, fr, fq, lds, wid, lane); S.done(cur); }
#undef PG8_SA
#undef PG8_SB
#undef PG8_STAGE
#undef PG8_LDA
#undef PG8_LDB
#undef PG8_MMA
#undef PG8_WAIT_V
#undef PG8_WAIT_L
#undef PG8_BAR
#undef PG8_SCHED
}
}
#define LAS __attribute__((address_space(3)))
typedef unsigned short bf16_t;
typedef short bf16x8 __attribute__((ext_vector_type(8)));
typedef short s16x4 __attribute__((ext_vector_type(4)));
typedef float f32x4 __attribute__((ext_vector_type(4)));
typedef float f32x2 __attribute__((ext_vector_type(2)));
typedef float f32x16 __attribute__((ext_vector_type(16)));
typedef unsigned u32x4 __attribute__((ext_vector_type(4)));
typedef unsigned u32x2 __attribute__((ext_vector_type(2)));
typedef short v4i16_t __attribute__((ext_vector_type(4)));

constexpr int L = 16384, DM = 1024, DFF = 2816, NW = 8;
constexpr int EV_IN = 3072, OD_IN = 2048;
constexpr float EPS = 1e-6f;
constexpr size_t MiB = 1u << 20;
constexpr size_t WS_WEVIN = 0, WS_WEVOUT = 6 * MiB, WS_WODIN = 8 * MiB, WS_WODOUT = 12 * MiB, WS_WGLU = 14 * MiB, WS_WFFIN = 15 * MiB, WS_WFFOUT = 37 * MiB;
constexpr size_t WFFIN_STRIDE = (size_t)5632 * 1024 * 2, WFFOUT_STRIDE = (size_t)1024 * 2816 * 2;
constexpr size_t WS_AP = 48 * MiB;
constexpr size_t WS_PROJ = 80 * MiB;
constexpr size_t WS_YG = WS_PROJ + 64 * MiB;
constexpr size_t WS_CAT = 176 * MiB;
constexpr size_t WS_MODP = 208 * MiB;
constexpr size_t WS_MOD = 210 * MiB;
constexpr size_t WS_GM = WS_MOD + 64 * 1024;
constexpr size_t WS_BV = WS_GM + 64 * 1024;
constexpr size_t WS_ROWSS = 242 * MiB;
constexpr size_t WS_ROPE = 212 * MiB;
constexpr size_t WS_HEADV = 216 * MiB, WS_HEADG = 218 * MiB, WS_TAILG = 220 * MiB;
constexpr size_t WS_RETL = 222 * MiB, WS_RETC = 230 * MiB;
constexpr size_t WS_S5L = 238 * MiB, WS_S5C = 239 * MiB;
constexpr size_t WS_S5P = 240 * MiB;
constexpr size_t WS_S5A = WS_S5P + 64 * 1024;
constexpr size_t WS_CTL = 248 * MiB, CTL_BYTES = 65536;
constexpr size_t WS_END = 249 * MiB;
constexpr int LDS_STAGE = 131072;
constexpr int LDS_XG = 131072;
constexpr int LDS_CTL = 131072 + 4096;
constexpr int LDS_BYTES = 147456;

struct Args { const float* in[28]; float* out; unsigned char* ws; };
typedef __attribute__((address_space(4))) const unsigned char* kptr_t;
__device__ __forceinline__ kptr_t kargs_fresh() { kptr_t p = (kptr_t)__builtin_amdgcn_kernarg_segment_ptr(); asm volatile("" : "+s"(p)); return p; }
__device__ __forceinline__ kptr_t klaunder(kptr_t p) { asm volatile("" : "+s"(p)); return p; }
__device__ __forceinline__ const float* karg_in(kptr_t kp, int i) { return (const float*)(*(__attribute__((address_space(1))) const float* const __attribute__((address_space(4)))*)(kp + 8 * i)); }
__device__ __forceinline__ float* karg_out(kptr_t kp) { return (float*)(*(__attribute__((address_space(1))) float* const __attribute__((address_space(4)))*)(kp + 224)); }
__device__ __forceinline__ unsigned char* karg_ws(kptr_t kp) { return (unsigned char*)(*(__attribute__((address_space(1))) unsigned char* const __attribute__((address_space(4)))*)(kp + 232)); }

enum { I_X = 0, I_C, I_T5, I_MODW, I_MODB, I_N1G, I_N2G, I_FFIN, I_CONVW, I_CONVB, I_FFOUT, I_EVIN, I_EVOUT, I_DLAM, I_SUBLN, I_RELB, I_ODIN, I_ODOUT, I_LRE, I_LIM, I_LSTEP, I_BRE, I_BIM, I_CRE, I_CIM, I_S5D, I_GLU, I_FING };

__device__ __forceinline__ unsigned cvtpk(float lo, float hi) { unsigned r; asm volatile("v_cvt_pk_bf16_f32 %0, %1, %2" : "=v"(r) : "v"(lo), "v"(hi)); return r; }
__device__ __forceinline__ float bf_lo(unsigned w) { return __uint_as_float(w << 16); }
__device__ __forceinline__ float bf_hi(unsigned w) { return __uint_as_float(w & 0xffff0000u); }
__device__ __forceinline__ float bf1(bf16_t v) { return __uint_as_float(((unsigned)v) << 16); }
__device__ __forceinline__ float wave_sum(float v) {
#pragma unroll
    for (int o = 1; o < 64; o <<= 1) v += __shfl_xor(v, o);
    return v;
}
__device__ __forceinline__ float half_sum(float v) {
#pragma unroll
    for (int o = 1; o < 32; o <<= 1) v += __shfl_xor(v, o);
    return v;
}
__device__ __forceinline__ float swap32f(float v) { return __shfl_xor(v, 32); }
__device__ __forceinline__ int crow(int r, int hi) { return (r & 3) + 8 * (r >> 2) + 4 * hi; }
#define LDSW() asm volatile("s_waitcnt lgkmcnt(0)" ::: "memory")
#define VMW() asm volatile("s_waitcnt vmcnt(0)" ::: "memory")
__device__ __forceinline__ void bar_sync() { asm volatile("s_waitcnt vmcnt(0) lgkmcnt(0)" ::: "memory"); __builtin_amdgcn_s_barrier(); asm volatile("" ::: "memory"); }
__device__ __forceinline__ float sigmoidf_(float x) { return __builtin_amdgcn_rcpf(1.0f + __builtin_amdgcn_exp2f(-1.4426950408889634f * x)); }
__device__ __forceinline__ float gelu_t(float x) { const float u = 0.7978845608028654f * (x + 0.044715f * x * x * x); return x * __builtin_amdgcn_rcpf(1.0f + __builtin_amdgcn_exp2f(-2.8853900817779268f * u)); }

__device__ __forceinline__ void sincos_d(double x, double& s, double& c) {
    const double n = __builtin_rint(x * 0.63661977236758134308);
    double r = __builtin_fma(-n, 1.57079632673412561417e+00, x);
    r = __builtin_fma(-n, 6.07710050630396597660e-11, r);
    r = __builtin_fma(-n, 2.02226624879595063154e-21, r);
    const double z = r * r;
    double ps = -1.0 / 1307674368000.0;
    ps = __builtin_fma(ps, z, 1.0 / 6227020800.0);
    ps = __builtin_fma(ps, z, -1.0 / 39916800.0);
    ps = __builtin_fma(ps, z, 1.0 / 362880.0);
    ps = __builtin_fma(ps, z, -1.0 / 5040.0);
    ps = __builtin_fma(ps, z, 1.0 / 120.0);
    ps = __builtin_fma(ps, z, -1.0 / 6.0);
    const double sr = __builtin_fma(ps * z, r, r);
    double pc = 1.0 / 20922789888000.0;
    pc = __builtin_fma(pc, z, -1.0 / 87178291200.0);
    pc = __builtin_fma(pc, z, 1.0 / 479001600.0);
    pc = __builtin_fma(pc, z, -1.0 / 3628800.0);
    pc = __builtin_fma(pc, z, 1.0 / 40320.0);
    pc = __builtin_fma(pc, z, -1.0 / 720.0);
    pc = __builtin_fma(pc, z, 1.0 / 24.0);
    pc = __builtin_fma(pc, z, -0.5);
    const double cr = __builtin_fma(pc, z, 1.0);
    const int q = ((int)(long long)n) & 3;
    s = (q == 0) ? sr : (q == 1) ? cr : (q == 2) ? -sr : -cr;
    c = (q == 0) ? cr : (q == 1) ? -sr : (q == 2) ? -cr : sr;
}

__device__ __forceinline__ int dst_row(int n, int N, int mode) {
    if (mode == 1) { if (n < 512) { const int j = n & 63; return (n & ~63) + ((j < 32) ? 2 * j : 2 * (j - 32) + 1); } return n; }
    if (mode == 2) { const int half = N >> 1, bj = n / half, rem = n - bj * half; return 256 * (rem >> 7) + 128 * bj + (rem & 127); }
    return n;
}
__device__ __forceinline__ void transpose_item(const float* W, int K, int N, bf16_t* WT, int mode, LAS float* scr, int item, int lane) {
    const int nblk = N / 32, kb = item / nblk, nb = item % nblk, k0 = 64 * kb, n0 = 32 * nb;
#pragma unroll 8
    for (int i = 0; i < 32; ++i) { const int kk = 2 * i + (lane >> 5); scr[kk * 33 + (lane & 31)] = W[(size_t)(k0 + kk) * N + n0 + (lane & 31)]; }
    LDSW();
    const int c = lane & 7;
#pragma unroll
    for (int j = 0; j < 4; ++j) { const int n = (lane >> 3) + 8 * j; const LAS float* s = scr + (8 * c) * 33 + n;
        u32x4 o; o.x = cvtpk(s[0 * 33], s[1 * 33]); o.y = cvtpk(s[2 * 33], s[3 * 33]); o.z = cvtpk(s[4 * 33], s[5 * 33]); o.w = cvtpk(s[6 * 33], s[7 * 33]);
        *(u32x4*)(WT + (size_t)dst_row(n0 + n, N, mode) * K + k0 + 8 * c) = o; }
    LDSW();
}
__device__ __forceinline__ void phase_p0a(kptr_t kp0, LAS unsigned char* lds, int vcu, int G) { const kptr_t kp = klaunder(kp0);
    const int tid = tid_opaque(), lane = tid & 63, wid = tid >> 6;
    unsigned char* ws = karg_ws(kp);
    LAS float* scr = (LAS float*)(lds + wid * 16384);
    const int gw = vcu * NW + wid, NGW = G * NW;
    constexpr int I0 = 16 * 96, I1 = 16 * 32, I2 = 16 * 64, I3 = 16 * 32, I4 = 8 * 32, I5 = 16 * 176, I6 = 44 * 32;
    constexpr int NIT = I0 + I1 + I2 + I3 + I4 + 2 * I5 + 2 * I6;
#pragma unroll 1
    for (int it = gw; it < NIT; it += NGW) {
        int r = it; const float* W; bf16_t* WT; int K, N, mode = 0;
        if (r < I0) { W = karg_in(kp, I_EVIN); WT = (bf16_t*)(ws + WS_WEVIN); K = 1024; N = 3072; }
        else if ((r -= I0) < I1) { W = karg_in(kp, I_EVOUT); WT = (bf16_t*)(ws + WS_WEVOUT); K = 1024; N = 1024; }
        else if ((r -= I1) < I2) { W = karg_in(kp, I_ODIN); WT = (bf16_t*)(ws + WS_WODIN); K = 1024; N = 2048; mode = 1; }
        else if ((r -= I2) < I3) { W = karg_in(kp, I_ODOUT); WT = (bf16_t*)(ws + WS_WODOUT); K = 1024; N = 1024; }
        else if ((r -= I3) < I4) { W = karg_in(kp, I_GLU); WT = (bf16_t*)(ws + WS_WGLU); K = 512; N = 1024; mode = 2; }
        else if ((r -= I4) < 2 * I5) { const int l = r / I5; r -= l * I5; W = karg_in(kp, I_FFIN) + (size_t)l * 1024 * 5632; WT = (bf16_t*)(ws + WS_WFFIN + l * WFFIN_STRIDE); K = 1024; N = 5632; mode = 2; }
        else { r -= 2 * I5; const int l = r / I6; r -= l * I6; W = karg_in(kp, I_FFOUT) + (size_t)l * 2816 * 1024; WT = (bf16_t*)(ws + WS_WFFOUT + l * WFFOUT_STRIDE); K = 2816; N = 1024; }
        transpose_item(W, K, N, WT, mode, scr, r, lane);
    }
    for (int b = vcu; b < 256; b += G) {
        const int kb = b >> 3, cg = b & 7;
        float accv[3] = {0.f, 0.f, 0.f};
        for (int kk = 0; kk < 32; ++kk) { const int k = kb * 32 + kk; const float cv = karg_in(kp, I_C)[k]; const float cond = cv * sigmoidf_(cv);
#pragma unroll
            for (int j = 0; j < 3; ++j) { const int cidx = cg * 1536 + tid + 512 * j, ly = cidx / 6144, n = cidx - ly * 6144; accv[j] += cond * karg_in(kp, I_MODW)[((size_t)ly * 1024 + k) * 6144 + n]; } }
#pragma unroll
        for (int j = 0; j < 3; ++j) ((float*)(ws + WS_MODP))[(size_t)kb * 12288 + cg * 1536 + tid + 512 * j] = accv[j];
    }
    const int gid = vcu * 512 + tid, GN = G * 512;
    for (int e = gid; e < 2048; e += GN) { const int g = e >> 6;
        const double step = exp((double)karg_in(kp, I_LSTEP)[g]); const double lre = karg_in(kp, I_LRE)[e], lim = karg_in(kp, I_LIM)[e];
        const double mag = exp(lre * step); double sn, cs; sincos_d(lim * step, sn, cs);
        const double dar = mag * cs, dai = mag * sn, nr = dar - 1.0, ni = dai, den = lre * lre + lim * lim;
        ((f32x4*)(ws + WS_S5P))[e] = (f32x4){(float)dar, (float)dai, (float)((nr * lre + ni * lim) / den), (float)((ni * lre - nr * lim) / den)};
        const double mag2 = exp(lre * step * 256.0); sincos_d(lim * step * 256.0, sn, cs);
        ((f32x2*)(ws + WS_S5A))[e] = (f32x2){(float)(mag2 * cs), (float)(mag2 * sn)}; }
    for (int e = gid; e < L * 32; e += GN) { const int pos = e >> 5, i = e & 31;
        const float pf = (float)exp2(13.287712379549449 * (double)i / 32.0);
        const float inv = 1.0f / pf; const float ang = (float)pos * inv;
        double s, c; sincos_d((double)ang, s, c);
        ((f32x2*)(ws + WS_ROPE))[e] = (f32x2){(float)c, (float)s}; }
}
__device__ __forceinline__ void phase_p0b(kptr_t kp0, int vcu, int G) { const kptr_t kp = klaunder(kp0);
    const int gid = vcu * 512 + tid_opaque(), GN = G * 512;
    const float* mp = (const float*)(karg_ws(kp) + WS_MODP);
    for (int c = gid; c < 12288; c += GN) { float s = karg_in(kp, I_MODB)[c];
        for (int kb = 0; kb < 32; ++kb) s += mp[(size_t)kb * 12288 + c];
        ((float*)(karg_ws(kp) + WS_MOD))[c] = s; }
}
__device__ __forceinline__ void phase_p0c(kptr_t kp0, int vcu, int G) { const kptr_t kp = klaunder(kp0);
    const int tid = tid_opaque(), lane = tid & 63, wid = tid >> 6;
    const int gid = vcu * 512 + tid, GN = G * 512, gw = vcu * NW + wid, NGW = G * NW;
    const float* mod = (const float*)(karg_ws(kp) + WS_MOD);
    float* gm = (float*)(karg_ws(kp) + WS_GM);
    for (int i = gid; i < 4096; i += GN) { const int v = i >> 10, k = i & 1023, ly = v >> 1, second = v & 1;
        const float g = (second ? karg_in(kp, I_N2G) : karg_in(kp, I_N1G))[ly * 1024 + k]; const float sc = mod[ly * 6144 + (second ? 4096 : 1024) + k];
        gm[i] = g * (1.0f + sc); }
    f32x4 gv[4];
#pragma unroll
    for (int j = 0; j < 4; ++j) { const int k = 4 * lane + 256 * j; const f32x4 g = *(const f32x4*)(karg_in(kp, I_N1G) + k), sc = *(const f32x4*)(mod + 1024 + k); gv[j] = g * (sc + 1.0f); }
    bf16_t* AP = (bf16_t*)(karg_ws(kp) + WS_AP); float* rowss = (float*)(karg_ws(kp) + WS_ROWSS);
    for (int m = gw; m < L; m += NGW) {
        const f32x4* xr = (const f32x4*)(karg_in(kp, I_X) + (size_t)m * 1024) + lane; float s = 0.f; f32x4 v[4];
#pragma unroll
        for (int j = 0; j < 4; ++j) { v[j] = xr[64 * j]; s += (v[j][0] * v[j][0] + v[j][1] * v[j][1]) + (v[j][2] * v[j][2] + v[j][3] * v[j][3]); }
        s = wave_sum(s);
        u32x2* o8 = (u32x2*)(AP + (size_t)m * 1024) + lane;
#pragma unroll
        for (int j = 0; j < 4; ++j) { const f32x4 t = v[j] * gv[j]; o8[64 * j] = (u32x2){cvtpk(t[0], t[1]), cvtpk(t[2], t[3])}; }
        if (lane < 16) rowss[(size_t)m * 16 + lane] = (lane == 0) ? s : 0.f;
    }
    float* bvec = (float*)(karg_ws(kp) + WS_BV);
    for (int r = gw; r < 16384; r += NGW) {
        const bf16_t* wrow; const float* sh;
        if (r < 3072) { wrow = (const bf16_t*)(karg_ws(kp) + WS_WEVIN) + (size_t)r * 1024; sh = mod; }
        else if (r < 5120) { wrow = (const bf16_t*)(karg_ws(kp) + WS_WODIN) + (size_t)(r - 3072) * 1024; sh = mod + 6144; }
        else if (r < 10752) { wrow = (const bf16_t*)(karg_ws(kp) + WS_WFFIN) + (size_t)(r - 5120) * 1024; sh = mod + 3072; }
        else { wrow = (const bf16_t*)(karg_ws(kp) + WS_WFFIN + WFFIN_STRIDE) + (size_t)(r - 10752) * 1024; sh = mod + 6144 + 3072; }
        float s = 0.f;
#pragma unroll
        for (int j = 0; j < 2; ++j) { const int k = 8 * lane + 512 * j; const u32x4 w = *(const u32x4*)(wrow + k); const f32x4 s0 = *(const f32x4*)(sh + k), s1 = *(const f32x4*)(sh + k + 4);
            s += bf_lo(w.x) * s0[0] + bf_hi(w.x) * s0[1] + bf_lo(w.y) * s0[2] + bf_hi(w.y) * s0[3] + bf_lo(w.z) * s1[0] + bf_hi(w.z) * s1[1] + bf_lo(w.w) * s1[2] + bf_hi(w.w) * s1[3]; }
        s = wave_sum(s);
        if (lane == 0) bvec[r] = s;
    }
}
constexpr int AT_STG = 32768;
constexpr int AT_BIAS = 65536, AT_WSF = 65536 + 1024, AT_POST = 0;
constexpr float AT_THR = 8.0f;
__device__ __forceinline__ bf16x8 tr_frag(const LAS unsigned char* p) {
    const s16x4 lo = __builtin_bit_cast(s16x4, __builtin_amdgcn_ds_read_tr16_b64_v4i16((LAS v4i16_t*)p));
    const s16x4 hi = __builtin_bit_cast(s16x4, __builtin_amdgcn_ds_read_tr16_b64_v4i16((LAS v4i16_t*)(p + 512)));
    return (bf16x8){lo[0], lo[1], lo[2], lo[3], hi[0], hi[1], hi[2], hi[3]};
}
__device__ __forceinline__ bf16x8 pack8(const f32x16& p, int b) {
    u32x4 w; w.x = cvtpk(p[b], p[b + 1]); w.y = cvtpk(p[b + 2], p[b + 3]); w.z = cvtpk(p[b + 4], p[b + 5]); w.w = cvtpk(p[b + 6], p[b + 7]);
    return __builtin_bit_cast(bf16x8, w);
}
#define MFMA32(a, b, c) __builtin_amdgcn_mfma_f32_32x32x16_bf16(a, b, c, 0, 0, 0)

template <int DV, bool DIFF>
__device__ __forceinline__ void attn_unit(LAS unsigned char* lds, const bf16_t* proj, bf16_t* cat, int h, int q0, int T0, int T1,
                                          int qcol, int kcol, int vcol, int ocol, float lam, const float* subg, float lam_init) {
    constexpr int ND = DV / 32, NV = DV / 64, VOFF = DIFF ? 16384 : 8192;
    const int tid = tid_opaque(), lane = tid & 63, r32 = lane & 31, hi = lane >> 5; const int wid = __builtin_amdgcn_readfirstlane(tid >> 6);
    const int wq = DIFF ? (wid & 3) : wid, sub = DIFF ? (wid >> 2) : 0;
    const int rowbase = q0 + 32 * wq, cw = rowbase >> 6;
    const int tlo = DIFF ? 0 : (cw - 8), thi = cw;
    LAS float* btab = (LAS float*)(lds + AT_BIAS);
    LAS float* wsf = (LAS float*)(lds + AT_WSF) + wid * 64;
    bf16x8 qr[4];
    { const bf16_t* Qw = proj + (size_t)(rowbase + r32) * EV_IN + qcol + sub * 64 + hi * 8;
#pragma unroll
      for (int d0 = 0; d0 < 4; ++d0) qr[d0] = *(const bf16x8*)(Qw + d0 * 16); }
    const bf16_t* ksrc = proj + (size_t)lane * EV_IN + kcol + wid * 8;
    const bf16_t* vsrc = proj + (size_t)(16 * (wid & 3) + (lane >> 2)) * EV_IN + vcol + (wid >> 2) * 32 + (lane & 3) * 8;
    const int kdst = wid * 1024 + lane * 16, vdst = VOFF + (wid >> 2) * 4096 + (wid & 3) * 1024 + lane * 16;
    u32x4 sk0, sk1 = (u32x4){0u, 0u, 0u, 0u}, sv[NV];
#define AT_GLOAD(t_) do { const size_t ro_ = (size_t)(t_) * 64 * EV_IN; sk0 = *(const u32x4*)(ksrc + ro_); if (DIFF) sk1 = *(const u32x4*)(ksrc + ro_ + 64); \
        _Pragma("unroll") for (int j_ = 0; j_ < NV; ++j_) sv[j_] = *(const u32x4*)(vsrc + ro_ + j_ * 64); } while (0)
#define AT_LSTORE(s_) do { LAS unsigned char* st_ = lds + (s_) * AT_STG; *(LAS u32x4*)(st_ + kdst) = sk0; if (DIFF) *(LAS u32x4*)(st_ + 8192 + kdst) = sk1; \
        _Pragma("unroll") for (int j_ = 0; j_ < NV; ++j_) *(LAS u32x4*)(st_ + vdst + j_ * 8192) = sv[j_]; } while (0)
    float mref = -1e30f, lsum = 0.f;
    f32x16 o[ND];
#pragma unroll
    for (int d = 0; d < ND; ++d) o[d] = (f32x16){};
    const int kfo = (DIFF ? sub * 8192 : 0) + hi * 1024 + r32 * 16;
    const int vfo = VOFF + ((lane >> 4) & 1) * 32 + (lane & 3) * 8 + (4 * hi + ((lane & 15) >> 2)) * 64;
    AT_GLOAD(T0); AT_LSTORE(0); bar_sync();
    for (int t = T0; t <= T1; ++t) {
        const int s = (t - T0) & 1;
        if (t < T1) AT_GLOAD(t + 1);
        if (t >= tlo && t <= thi) {
            const LAS unsigned char* st = lds + s * AT_STG;
            f32x16 p0 = (f32x16){}, p1 = (f32x16){};
#pragma unroll
            for (int d0 = 0; d0 < 4; ++d0) {
                const bf16x8 b0 = *(const LAS bf16x8*)(st + kfo + d0 * 2048), b1 = *(const LAS bf16x8*)(st + kfo + d0 * 2048 + 512);
                p0 = MFMA32(b0, qr[d0], p0); p1 = MFMA32(b1, qr[d0], p1); }
            if (t >= cw - 2) {
                const int ib = 64 * t - (rowbase + r32) + 191 + 4 * hi;
#pragma unroll
                for (int r = 0; r < 16; ++r) { const int kv = (r & 3) + 8 * (r >> 2); p0[r] += btab[ib + kv]; p1[r] += btab[ib + kv + 32]; }
            }
            float rm = p0[0];
#pragma unroll
            for (int r = 1; r < 16; ++r) rm = fmaxf(rm, p0[r]);
#pragma unroll
            for (int r = 0; r < 16; ++r) rm = fmaxf(rm, p1[r]);
            rm = fmaxf(rm, swap32f(rm));
            if (__any(rm > mref + AT_THR)) {
                const float mnew = fmaxf(mref, rm), f = __builtin_amdgcn_exp2f(mref - mnew);
                mref = mnew; lsum *= f;
                if (hi == 0) wsf[r32] = f;
                LDSW();
#pragma unroll
                for (int r = 0; r < 16; ++r) { const float fr_ = wsf[crow(r, hi)];
#pragma unroll
                    for (int d = 0; d < ND; ++d) o[d][r] *= fr_; }
            }
            float sacc = 0.f;
#pragma unroll
            for (int r = 0; r < 16; ++r) { p0[r] = __builtin_amdgcn_exp2f(p0[r] - mref); p1[r] = __builtin_amdgcn_exp2f(p1[r] - mref); sacc += p0[r] + p1[r]; }
            lsum += sacc;
            const bf16x8 pw0 = pack8(p0, 0), pw1 = pack8(p0, 8), pw2 = pack8(p1, 0), pw3 = pack8(p1, 8);
#pragma unroll
            for (int d = 0; d < ND; ++d) {
                const LAS unsigned char* vp = st + vfo + d * 4096;
                o[d] = MFMA32(pw0, tr_frag(vp), o[d]); o[d] = MFMA32(pw1, tr_frag(vp + 1024), o[d]);
                o[d] = MFMA32(pw2, tr_frag(vp + 2048), o[d]); o[d] = MFMA32(pw3, tr_frag(vp + 3072), o[d]); }
        }
        if (t < T1) AT_LSTORE(s ^ 1);
        bar_sync();
    }
    lsum += swap32f(lsum);
    if (hi == 0) wsf[32 + r32] = 1.0f / lsum;
    LDSW();
#pragma unroll
    for (int r = 0; r < 16; ++r) { const float inv = wsf[32 + crow(r, hi)];
#pragma unroll
        for (int d = 0; d < ND; ++d) o[d][r] *= inv; }
    if (DIFF) {
        LAS float* xo = (LAS float*)(lds + AT_POST) + wq * 4096;
        if (sub == 1) {
#pragma unroll
            for (int r = 0; r < 16; ++r)
#pragma unroll
                for (int d = 0; d < ND; ++d) xo[crow(r, hi) * 128 + 32 * d + r32] = o[d][r];
        }
        bar_sync();
        LAS bf16_t* stg = (LAS bf16_t*)(lds + 65536 + 4096) + wq * 4096;
        if (sub == 0) {
            float gl[ND];
#pragma unroll
            for (int d = 0; d < ND; ++d) gl[d] = subg[32 * d + r32] * (1.0f - lam_init);
#pragma unroll
            for (int r = 0; r < 16; ++r) { float ss = 0.f;
#pragma unroll
                for (int d = 0; d < ND; ++d) { o[d][r] -= lam * xo[crow(r, hi) * 128 + 32 * d + r32]; ss += o[d][r] * o[d][r]; }
                ss = half_sum(ss);
                const float rs = 1.0f / sqrtf(ss * (1.0f / 128.0f) + EPS);
#pragma unroll
                for (int d = 0; d < ND; ++d) stg[crow(r, hi) * 128 + 32 * d + r32] = (bf16_t)(cvtpk(o[d][r] * rs * gl[d], 0.f) & 0xffffu); }
            LDSW();
#pragma unroll
            for (int i = 0; i < 8; ++i) { const int row = i * 4 + (lane >> 4), ch = lane & 15; const u32x4 v = *(const LAS u32x4*)(stg + row * 128 + ch * 8);
                *(u32x4*)(cat + (size_t)(rowbase + row) * 1024 + ocol + ch * 8) = v; }
        }
        bar_sync();
    } else {
        LAS bf16_t* stg = (LAS bf16_t*)(lds + AT_POST) + wid * 2048;
#pragma unroll
        for (int r = 0; r < 16; ++r)
#pragma unroll
            for (int d = 0; d < ND; ++d) stg[crow(r, hi) * 64 + 32 * d + r32] = (bf16_t)(cvtpk(o[d][r], 0.f) & 0xffffu);
        LDSW();
#pragma unroll
        for (int i = 0; i < 4; ++i) { const int row = i * 8 + (lane >> 3), ch = lane & 7; const u32x4 v = *(const LAS u32x4*)(stg + row * 64 + ch * 8);
            *(u32x4*)(cat + (size_t)(rowbase + row) * 1024 + ocol + ch * 8) = v; }
        bar_sync();
    }
}
__device__ __forceinline__ int t5_bucket(int rel) {
    const int n = rel < 0 ? -rel : rel; int b = rel > 0 ? 16 : 0;
    if (n < 8) return b + n;
    int lg = 31 - __builtin_clz((unsigned)((n * n) >> 6)); lg = 8 + lg; if (lg > 15) lg = 15;
    return b + lg;
}
__device__ __forceinline__ void phase_attn(kptr_t kp0, LAS unsigned char* lds, int vcu, int G) { const kptr_t kp = klaunder(kp0);
    const int tid = tid_opaque();
    const bf16_t* proj = (const bf16_t*)(karg_ws(kp) + WS_PROJ); bf16_t* cat = (bf16_t*)(karg_ws(kp) + WS_CAT);
    LAS float* btab = (LAS float*)(lds + AT_BIAS);
    const float lam_init = 0.2f;
    float d1 = 0.f, d2 = 0.f;
    for (int i = 0; i < 64; ++i) { d1 += karg_in(kp, I_DLAM)[i] * karg_in(kp, I_DLAM)[64 + i]; d2 += karg_in(kp, I_DLAM)[128 + i] * karg_in(kp, I_DLAM)[192 + i]; }
    const float lam = expf(d1) - expf(d2) + lam_init;
    for (int pu = vcu; pu < 256; pu += G) {
        const int h = pu >> 6, pr = pu & 63;
        if (tid < 255) { const int rel = tid - 191; btab[tid] = (karg_in(kp, I_T5)[t5_bucket(rel) * 4 + h] - karg_in(kp, I_T5)[15 * 4 + h]) * 1.4426950408889634f; }
        bar_sync();
        for (int k = 0; k < 2; ++k) { const int qb = k ? (127 - pr) : pr;
            attn_unit<128, true>(lds, proj, cat, h, 128 * qb, 0, 2 * qb + 1, h * 128, 512 + h * 128, 1024 + h * 128, h * 128, lam, karg_in(kp, I_SUBLN), lam_init); }
    }
    for (int bu = vcu; bu < 512; bu += G) {
        const int h = bu >> 6, blk = bu & 63;
        bar_sync();
        if (tid < 255) { int rel = tid - 191; if (rel < -128) rel = -128; btab[tid] = (karg_in(kp, I_RELB)[h * 257 + rel + 128] - karg_in(kp, I_RELB)[h * 257]) * 1.4426950408889634f; }
        bar_sync();
        const int T0 = (4 * blk - 8) < 0 ? 0 : (4 * blk - 8);
        attn_unit<64, false>(lds, proj, cat, h, 256 * blk, T0, 4 * blk + 3, 1536 + h * 64, 2048 + h * 64, 2560 + h * 64, 512 + h * 64, 0.f, nullptr, 0.f);
    }
}
#define MFMA16(a, b, c) __builtin_amdgcn_mfma_f32_16x16x32_bf16(a, b, c, 0, 0, 0)
__device__ __forceinline__ float ret_lg2(int h) { return h == 0 ? -0.04580368961312479f : h == 1 ? -0.02272007650008353f : h == 2 ? -0.011315313227834146f : -0.005646563141142063f; }
__device__ __forceinline__ u32x4 scale8(u32x4 w, float s) {
    u32x4 o; o.x = cvtpk(bf_lo(w.x) * s, bf_hi(w.x) * s); o.y = cvtpk(bf_lo(w.y) * s, bf_hi(w.y) * s); o.z = cvtpk(bf_lo(w.z) * s, bf_hi(w.z) * s); o.w = cvtpk(bf_lo(w.w) * s, bf_hi(w.w) * s); return o;
}
__device__ __forceinline__ void phase_ret1(kptr_t kp0, LAS unsigned char* lds, int vcu, int G) { const kptr_t kp = klaunder(kp0);
    const int tid = tid_opaque(), lane = tid & 63, r32 = lane & 31, hi = lane >> 5; const int wid = __builtin_amdgcn_readfirstlane(tid >> 6);
    const bf16_t* proj = (const bf16_t*)(karg_ws(kp) + WS_PROJ); float* retl = (float*)(karg_ws(kp) + WS_RETL);
    const int lanepat = ((lane >> 4) & 1) * 32 + (lane & 3) * 8 + (4 * hi + ((lane & 15) >> 2)) * 64;
    for (int item = vcu; item < 256; item += G) {
        const int h = item & 3, grp = item >> 2, R0 = 256 * grp; const float lg2 = ret_lg2(h);
#pragma unroll
        for (int i = 0; i < 4; ++i) { const int p = tid + 512 * i, j = p >> 3, c = p & 7;
            const u32x4 w = *(const u32x4*)(proj + (size_t)(R0 + j) * OD_IN + 256 + h * 64 + 8 * c);
            *(LAS u32x4*)(lds + (c >> 2) * 16384 + (j >> 4) * 1024 + (j & 15) * 64 + (c & 3) * 16) = scale8(w, __builtin_amdgcn_exp2f(lg2 * (float)(255 - j))); }
#pragma unroll
        for (int i = 0; i < 8; ++i) { const int p = tid + 512 * i, j = p >> 4, c = p & 15;
            const u32x4 w = *(const u32x4*)(proj + (size_t)(R0 + j) * OD_IN + 512 + h * 128 + 8 * c);
            *(LAS u32x4*)(lds + 32768 + (c >> 2) * 16384 + (j >> 4) * 1024 + (j & 15) * 64 + (c & 3) * 16) = w; }
        bar_sync();
        const int db = wid >> 2, eb = wid & 3;
        f32x16 acc = (f32x16){};
#pragma unroll 4
        for (int ks = 0; ks < 16; ++ks) acc = MFMA32(tr_frag(lds + db * 16384 + ks * 1024 + lanepat), tr_frag(lds + 32768 + eb * 16384 + ks * 1024 + lanepat), acc);
        float* dst = retl + ((size_t)(grp * 4 + h) * 64 + 32 * db) * 128 + 32 * eb + r32;
#pragma unroll
        for (int r = 0; r < 16; ++r) dst[crow(r, hi) * 128] = acc[r];
        bar_sync();
    }
}
constexpr int RT_ST = 65536, RT_STB = 18432, RT_RS = 65536 + 2 * 18432;
__device__ __forceinline__ void phase_ret2(kptr_t kp0, LAS unsigned char* lds, int vcu, int G) { const kptr_t kp = klaunder(kp0);
    const int tid = tid_opaque(), lane = tid & 63, r32 = lane & 31, hi = lane >> 5; const int wid = __builtin_amdgcn_readfirstlane(tid >> 6);
    const bf16_t* proj = (const bf16_t*)(karg_ws(kp) + WS_PROJ); const float* retc = (const float*)(karg_ws(kp) + WS_RETC); bf16_t* cat = (bf16_t*)(karg_ws(kp) + WS_CAT);
    const int lanepat = ((lane >> 4) & 1) * 32 + (lane & 3) * 8 + (4 * hi + ((lane & 15) >> 2)) * 64;
    const int ib = wid >> 2, db = wid >> 2, eb = wid & 3;
    for (int item = vcu; item < 256; item += G) {
        const int h = item & 3, grp = item >> 2, R0 = 256 * grp; const float lg2 = ret_lg2(h); const float cd = __builtin_amdgcn_exp2f(lg2 * 64.0f);
        const bf16_t* kcs = proj + (size_t)(R0 + lane) * OD_IN + 256 + h * 64 + wid * 8;
        const int kcd = wid * 1024 + lane * 16;
        const int srow = 16 * (wid & 3) + (lane >> 2);
        const bf16_t* kds = proj + (size_t)(R0 + srow) * OD_IN + 256 + h * 64 + (wid >> 2) * 32 + (lane & 3) * 8;
        const int kdd = 8192 + (wid >> 2) * 4096 + (wid & 3) * 1024 + lane * 16;
        const bf16_t* vvs = proj + (size_t)(R0 + srow) * OD_IN + 512 + h * 128 + (wid >> 2) * 32 + (lane & 3) * 8;
        const int vvd = 16384 + (wid >> 2) * 4096 + (wid & 3) * 1024 + lane * 16;
        const float kdsc = __builtin_amdgcn_exp2f(lg2 * (float)(63 - srow));
        u32x4 s_kc, s_kd, s_v0, s_v1;
#define RT_GLOAD(c_) do { const size_t ro_ = (size_t)(c_) * 64 * OD_IN; s_kc = *(const u32x4*)(kcs + ro_); s_kd = *(const u32x4*)(kds + ro_); s_v0 = *(const u32x4*)(vvs + ro_); s_v1 = *(const u32x4*)(vvs + ro_ + 64); } while (0)
#define RT_LSTORE(s_) do { LAS unsigned char* st_ = lds + (s_) * 32768; *(LAS u32x4*)(st_ + kcd) = s_kc; *(LAS u32x4*)(st_ + kdd) = scale8(s_kd, kdsc); *(LAS u32x4*)(st_ + vvd) = s_v0; *(LAS u32x4*)(st_ + vvd + 8192) = s_v1; } while (0)
        f32x16 S;
        { const float* src = retc + ((size_t)(grp * 4 + h) * 64 + 32 * db) * 128 + 32 * eb + r32;
#pragma unroll
          for (int r = 0; r < 16; ++r) S[r] = src[crow(r, hi) * 128]; }
#define RT_STWRITE(sb_) do { LAS unsigned char* sp_ = lds + RT_ST + (sb_) * RT_STB + (32 * eb + r32) * 144 + (32 * db + 4 * hi) * 2; \
        _Pragma("unroll") for (int r4_ = 0; r4_ < 4; ++r4_) *(LAS u32x2*)(sp_ + r4_ * 16) = (u32x2){cvtpk(S[4 * r4_], S[4 * r4_ + 1]), cvtpk(S[4 * r4_ + 2], S[4 * r4_ + 3])}; } while (0)
        RT_STWRITE(0);
        RT_GLOAD(0); RT_LSTORE(0);
        bar_sync();
#pragma unroll 1
        for (int c = 0; c < 4; ++c) {
            const int s = c & 1, Rc = R0 + 64 * c;
            if (c < 3) RT_GLOAD(c + 1);
            const LAS unsigned char* st = lds + s * 32768;
            bf16x8 qr[4];
            { const bf16_t* Qw = proj + (size_t)(Rc + 32 * ib + r32) * OD_IN + h * 64 + hi * 8;
#pragma unroll
              for (int d0 = 0; d0 < 4; ++d0) qr[d0] = *(const bf16x8*)(Qw + d0 * 16); }
            f32x16 p0 = (f32x16){}, p1 = (f32x16){};
            const int kfo = hi * 1024 + r32 * 16;
#pragma unroll
            for (int d0 = 0; d0 < 4; ++d0) {
                const bf16x8 b0 = *(const LAS bf16x8*)(st + kfo + d0 * 2048), b1 = *(const LAS bf16x8*)(st + kfo + d0 * 2048 + 512);
                p0 = MFMA32(b0, qr[d0], p0); p1 = MFMA32(b1, qr[d0], p1); }
            int iloc = 32 * ib + r32; asm volatile("" : "+v"(iloc));
            int hio = hi; asm volatile("" : "+v"(hio));
#pragma unroll
            for (int r = 0; r < 16; ++r) { const int j = crow(r, hio); int d0_ = iloc - j; d0_ = d0_ < 0 ? -d0_ : d0_; int d1_ = iloc - j - 32; d1_ = d1_ < 0 ? -d1_ : d1_;
                p0[r] *= __builtin_amdgcn_exp2f(lg2 * (float)d0_); p1[r] *= __builtin_amdgcn_exp2f(lg2 * (float)d1_); }
            const bf16x8 pw0 = pack8(p0, 0), pw1 = pack8(p0, 8), pw2 = pack8(p1, 0), pw3 = pack8(p1, 8);
            const LAS unsigned char* vp = st + 16384 + eb * 4096 + lanepat;
            f32x16 o = (f32x16){};
            o = MFMA32(pw0, tr_frag(vp), o); o = MFMA32(pw1, tr_frag(vp + 1024), o); o = MFMA32(pw2, tr_frag(vp + 2048), o); o = MFMA32(pw3, tr_frag(vp + 3072), o);
            f32x16 cx = (f32x16){};
            { const LAS unsigned char* sp = lds + RT_ST + s * RT_STB + (32 * eb + r32) * 144 + hi * 16;
#pragma unroll
              for (int d0 = 0; d0 < 4; ++d0) cx = MFMA32(qr[d0], *(const LAS bf16x8*)(sp + d0 * 32), cx); }
            LAS float* rsb = (LAS float*)(lds + RT_RS);
#pragma unroll
            for (int r = 0; r < 16; ++r) { const int i = 32 * ib + crow(r, hio); o[r] += __builtin_amdgcn_exp2f(lg2 * (float)(i + 1)) * cx[r];
                const float ss = half_sum(o[r] * o[r]); if (r32 == 0) rsb[i * 4 + eb] = ss; }
            { const LAS unsigned char* kp = st + 8192 + db * 4096 + lanepat; f32x16 kv = (f32x16){};
#pragma unroll
              for (int ks = 0; ks < 4; ++ks) kv = MFMA32(tr_frag(kp + ks * 1024), tr_frag(vp + ks * 1024), kv);
#pragma unroll
              for (int r = 0; r < 16; ++r) S[r] = cd * S[r] + kv[r]; }
            bar_sync();
#pragma unroll
            for (int r = 0; r < 16; ++r) { const int i = 32 * ib + crow(r, hi); const f32x4 q4 = *(const LAS f32x4*)(rsb + i * 4);
                const float rs = 1.0f / sqrtf(((q4[0] + q4[1]) + (q4[2] + q4[3])) * (1.0f / 128.0f) + EPS);
                const float g = bf1(proj[(size_t)(Rc + i) * OD_IN + 1024 + h * 128 + 32 * eb + r32]);
                cat[(size_t)(Rc + i) * 1024 + h * 128 + 32 * eb + r32] = (bf16_t)(cvtpk(o[r] * rs * g * sigmoidf_(g), 0.f) & 0xffffu); }
            RT_STWRITE(s ^ 1);
            if (c < 3) RT_LSTORE(s ^ 1);
            bar_sync();
        }
    }
#undef RT_GLOAD
#undef RT_LSTORE
#undef RT_STWRITE
}
template <bool PASS2>
__device__ __forceinline__ void phase_s5(kptr_t kp0, LAS unsigned char* lds, int vcu, int G) { const kptr_t kp = klaunder(kp0);
    const int tid = tid_opaque(), lane = tid & 63; const int wid = __builtin_amdgcn_readfirstlane(tid >> 6);
    const int gw = vcu * NW + wid, NGW = G * NW;
    const bf16_t* proj = (const bf16_t*)(karg_ws(kp) + WS_PROJ); bf16_t* yg = (bf16_t*)(karg_ws(kp) + WS_YG);
    LAS float* ubuf = (LAS float*)(lds + wid * 6144);
    LAS bf16_t* xt = (LAS bf16_t*)(lds + wid * 6144 + 1024);
    for (int wi = gw; wi < 2048; wi += NGW) {
        const int g = wi & 31, seg = wi >> 5, t0 = seg * 256, n = lane;
        float ar, ai, bbr[16], bbi[16];
        { const f32x4 prm = ((const f32x4*)(karg_ws(kp) + WS_S5P))[g * 64 + n]; ar = prm[0]; ai = prm[1]; const float cr = prm[2], ci = prm[3];
          const f32x4* br = (const f32x4*)(karg_in(kp, I_BRE) + ((size_t)g * 64 + n) * 16); const f32x4* bi = (const f32x4*)(karg_in(kp, I_BIM) + ((size_t)g * 64 + n) * 16);
#pragma unroll
          for (int q = 0; q < 4; ++q) { const f32x4 vr = br[q], vi = bi[q];
#pragma unroll
              for (int j = 0; j < 4; ++j) { bbr[4 * q + j] = cr * vr[j] - ci * vi[j]; bbi[4 * q + j] = cr * vi[j] + ci * vr[j]; } } }
        float xr = 0.f, xi = 0.f;
        bf16x8 cfr[4]; float dsk = 0.f;
        if (PASS2) {
            const f32x2 c0 = ((const f32x2*)(karg_ws(kp) + WS_S5C))[((size_t)g * 64 + seg) * 64 + n]; xr = c0[0]; xi = c0[1];
            const int p = lane & 15, kq = lane >> 4;
#pragma unroll
            for (int s = 0; s < 4; ++s) { const float* src = ((s < 2) ? karg_in(kp, I_CRE) : karg_in(kp, I_CIM)) + ((size_t)g * 16 + p) * 64 + 32 * (s & 1) + 8 * kq; const float sg = (s < 2) ? 1.0f : -1.0f;
                const f32x4 v0 = *(const f32x4*)src * sg, v1 = *(const f32x4*)(src + 4) * sg;
                u32x4 w; w.x = cvtpk(v0[0], v0[1]); w.y = cvtpk(v0[2], v0[3]); w.z = cvtpk(v1[0], v1[1]); w.w = cvtpk(v1[2], v1[3]); cfr[s] = __builtin_bit_cast(bf16x8, w); }
            dsk = karg_in(kp, I_S5D)[g * 16 + p];
        }
        const bf16_t* usrc = proj + (size_t)(t0 + (lane >> 2)) * OD_IN + 1536 + g * 16 + 4 * (lane & 3);
        u32x2 un = *(const u32x2*)usrc;
        for (int blk = 0; blk < 16; ++blk) {
            *(LAS f32x4*)(ubuf + (lane >> 2) * 16 + 4 * (lane & 3)) = (f32x4){bf_lo(un.x), bf_hi(un.x), bf_lo(un.y), bf_hi(un.y)};
            if (blk < 15) un = *(const u32x2*)(usrc + (size_t)(blk + 1) * 16 * OD_IN);
            LDSW();
#pragma unroll 4
            for (int tt = 0; tt < 16; ++tt) {
                const f32x4 u0 = *(const LAS f32x4*)(ubuf + tt * 16), u1 = *(const LAS f32x4*)(ubuf + tt * 16 + 4), u2 = *(const LAS f32x4*)(ubuf + tt * 16 + 8), u3 = *(const LAS f32x4*)(ubuf + tt * 16 + 12);
                float br_ = 0.f, bi_ = 0.f;
#pragma unroll
                for (int j = 0; j < 4; ++j) { br_ += bbr[j] * u0[j] + bbr[4 + j] * u1[j] + bbr[8 + j] * u2[j] + bbr[12 + j] * u3[j]; bi_ += bbi[j] * u0[j] + bbi[4 + j] * u1[j] + bbi[8 + j] * u2[j] + bbi[12 + j] * u3[j]; }
                const float nxr = ar * xr - ai * xi + br_, nxi = ar * xi + ai * xr + bi_;
                xr = nxr; xi = nxi;
                if (PASS2) { xt[tt * 136 + n] = (bf16_t)(cvtpk(xr, 0.f) & 0xffffu); xt[tt * 136 + 64 + n] = (bf16_t)(cvtpk(xi, 0.f) & 0xffffu); }
            }
            if (PASS2) {
                LDSW();
                f32x4 y = (f32x4){0.f, 0.f, 0.f, 0.f};
#pragma unroll
                for (int s = 0; s < 4; ++s) y = MFMA16(*(const LAS bf16x8*)(xt + (lane & 15) * 136 + 32 * s + 8 * (lane >> 4)), cfr[s], y);
                const int p = lane & 15;
#pragma unroll
                for (int i = 0; i < 4; ++i) { const int t = 4 * (lane >> 4) + i; const float v = y[i] + dsk * ubuf[t * 16 + p];
                    yg[(size_t)(t0 + blk * 16 + t) * 512 + g * 16 + p] = (bf16_t)(cvtpk(gelu_t(v), 0.f) & 0xffffu); }
            }
            LDSW();
        }
        if (!PASS2) ((f32x2*)(karg_ws(kp) + WS_S5L))[((size_t)g * 64 + seg) * 64 + n] = (f32x2){xr, xi};
    }
}
__device__ __forceinline__ void phase_scans(kptr_t kp0, int vcu, int G) { const kptr_t kp = klaunder(kp0);
    const int gid = vcu * 512 + tid_opaque(), GN = G * 512;
    for (int idx = gid; idx < 32768 + 2048; idx += GN) {
        if (idx < 32768) {
            const int h = idx >> 13, de = idx & 8191; const float cd4 = __builtin_amdgcn_exp2f(ret_lg2(h) * 256.0f);
            const float* src = (const float*)(karg_ws(kp) + WS_RETL) + (size_t)h * 8192 + de; float* dst = (float*)(karg_ws(kp) + WS_RETC) + (size_t)h * 8192 + de;
            float C = 0.f;
            for (int g0 = 0; g0 < 64; g0 += 8) { float e[8];
#pragma unroll
                for (int k = 0; k < 8; ++k) e[k] = src[(size_t)(g0 + k) * 32768];
#pragma unroll
                for (int k = 0; k < 8; ++k) { dst[(size_t)(g0 + k) * 32768] = C; C = cd4 * C + e[k]; } }
        } else {
            const int i2 = idx - 32768, g = i2 >> 6, n = i2 & 63;
            const f32x2 A256 = ((const f32x2*)(karg_ws(kp) + WS_S5A))[i2]; const float Ar = A256[0], Ai = A256[1];
            const f32x2* src = (const f32x2*)(karg_ws(kp) + WS_S5L) + (size_t)g * 4096 + n; f32x2* dst = (f32x2*)(karg_ws(kp) + WS_S5C) + (size_t)g * 4096 + n;
            float cr = 0.f, ci = 0.f;
            for (int s0 = 0; s0 < 64; s0 += 8) { f32x2 e[8];
#pragma unroll
                for (int k = 0; k < 8; ++k) e[k] = src[(s0 + k) * 64];
#pragma unroll
                for (int k = 0; k < 8; ++k) { dst[(s0 + k) * 64] = (f32x2){cr, ci}; const float nr = Ar * cr - Ai * ci + e[k][0], ni = Ar * ci + Ai * cr + e[k][1]; cr = nr; ci = ni; } }
        }
    }
}
__device__ __forceinline__ void ffn_fixup(kptr_t kp0, int layer, int pm) { const kptr_t kp = klaunder(kp0);
    if (pm > 0) {
        const float* hv = (const float*)(karg_ws(kp) + WS_HEADV) + (size_t)pm * 2 * 2816; const float* hg = (const float*)(karg_ws(kp) + WS_HEADG) + (size_t)pm * 2 * 2816;
        const float* tg = (const float*)(karg_ws(kp) + WS_TAILG) + (size_t)(pm - 1) * 2 * 2816;
        const float* cw = karg_in(kp, I_CONVW) + (size_t)layer * 3 * 2816; const float* cb = karg_in(kp, I_CONVB) + (size_t)layer * 2816;
        bf16_t* act = (bf16_t*)(karg_ws(kp) + WS_PROJ) + (size_t)pm * 256 * 2816;
        for (int f = tid_opaque(); f < 2816; f += 512) {
            const float gm2 = tg[f], gm1 = tg[2816 + f], g0 = hg[f], g1 = hg[2816 + f], w0 = cw[f], w1 = cw[2816 + f], w2 = cw[5632 + f], b = cb[f];
            act[f] = (bf16_t)(cvtpk(gelu_t(w0 * gm2 + w1 * gm1 + w2 * g0 + b) * hv[f], 0.f) & 0xffffu);
            act[2816 + f] = (bf16_t)(cvtpk(gelu_t(w0 * gm1 + w1 * g0 + w2 * g1 + b) * hv[2816 + f], 0.f) & 0xffffu);
        }
    }
    asm volatile("s_waitcnt vmcnt(0)" ::: "memory");
    __builtin_amdgcn_fence(__ATOMIC_RELEASE, "agent");
    __builtin_amdgcn_fence(__ATOMIC_ACQUIRE, "agent");
    asm volatile("s_waitcnt vmcnt(0)" ::: "memory");
    __syncthreads();
}
__device__ __forceinline__ void phase_final(kptr_t kp0, int vcu, int G) { const kptr_t kp = klaunder(kp0);
    const int tid_ = tid_opaque(), lane = tid_ & 63, wid = tid_ >> 6, gw = vcu * NW + wid, NGW = G * NW;
    const float* rowss = (const float*)(karg_ws(kp) + WS_ROWSS) + (size_t)4 * L * 16;
    f32x4 gv[4];
#pragma unroll
    for (int j = 0; j < 4; ++j) gv[j] = *(const f32x4*)(karg_in(kp, I_FING) + 4 * lane + 256 * j);
    for (int m = gw; m < L; m += NGW) {
        const float rs = 1.0f / sqrtf(wave_sum(lane < 16 ? rowss[(size_t)m * 16 + lane] : 0.f) * (1.0f / 1024.0f) + EPS);
        f32x4* xr = (f32x4*)(karg_out(kp) + (size_t)m * 1024) + lane;
#pragma unroll
        for (int j = 0; j < 4; ++j) xr[64 * j] = xr[64 * j] * rs * gv[j];
    }
}
#ifdef NO_G_PROJ
#define EN_PROJ 0
#else
#define EN_PROJ 1
#endif
#ifdef NO_G_RES1
#define EN_RES1 0
#else
#define EN_RES1 1
#endif
#ifdef NO_G_ROPE
#define EN_ROPE 0
#else
#define EN_ROPE 1
#endif
#ifdef NO_G_GLU
#define EN_GLU 0
#else
#define EN_GLU 1
#endif
#ifdef NO_G_RES2
#define EN_RES2 0
#else
#define EN_RES2 1
#endif
#ifdef NO_G_FFN
#define EN_FFN 0
#else
#define EN_FFN 1
#endif
#ifdef NO_G_RES3
#define EN_RES3 0
#else
#define EN_RES3 1
#endif
#ifdef NO_GSYNC
#define GSYNC() __syncthreads()
#else
#define GSYNC() xcd_barrier(xbar)
#endif
#define XB_TMO      128
#define XB_XCNT(j)  (256  + 64 * (j))
#define XB_XSUB(j)  (1280 + 64 * (j))
#define XB_XGEN(j)  (2304 + 64 * (j))
#define XB_TOP      3328
#define XB_TOPGEN   3392
#define XCD_BAR_WORDS 3456
#define XB_SPIN_CAP (1u << 18)

__device__ __forceinline__ unsigned xb_ld(unsigned* p)              { return __hip_atomic_load(p, __ATOMIC_RELAXED, __HIP_MEMORY_SCOPE_AGENT); }
__device__ __forceinline__ unsigned xb_add(unsigned* p, unsigned v) { return __hip_atomic_fetch_add(p, v, __ATOMIC_RELAXED, __HIP_MEMORY_SCOPE_AGENT); }
__device__ __forceinline__ unsigned xb_xcc_id() { return (unsigned)__builtin_amdgcn_s_getreg((3 << 11) | 20) & 0xFu; }
#define XB_SPIN(cond, bar) do { unsigned _sp = 0; while (cond) { __builtin_amdgcn_s_sleep(1); \
    if ((++_sp & 255u) == 0u) { if (xb_ld(&(bar)[XB_TMO])) break; if (_sp > XB_SPIN_CAP) { atomicAdd(&(bar)[XB_TMO], 1u); break; } } } } while (0)

struct XcdBarrier {
    unsigned* bar; unsigned x;
    volatile LAS unsigned* st;
};

__device__ __forceinline__ XcdBarrier xcd_barrier_post(unsigned* bar, volatile LAS unsigned* st) {
    XcdBarrier b; b.bar = bar; b.x = xb_xcc_id(); b.st = st;
    if (threadIdx.x == 0) (void)xb_add(&bar[XB_XCNT(b.x)], 1u);
    return b;
}
__device__ __forceinline__ void xcd_barrier_complete(unsigned* bar, unsigned x, unsigned& nloc, unsigned& nx) {
    const unsigned G = gridDim.x * gridDim.y * gridDim.z;
    unsigned sum, cnt, mine, sp = 0u;
    for (;;) {
        sum = 0u; cnt = 0u; mine = 0u;
#pragma unroll
        for (unsigned j = 0; j < 16; ++j) { const unsigned c = xb_ld(&bar[XB_XCNT(j)]); sum += c; cnt += (c > 0u) ? 1u : 0u; mine = (j == x) ? c : mine; }
        if (sum == G) break;
        __builtin_amdgcn_s_sleep(1);
        if ((++sp & 255u) == 0u) { if (xb_ld(&bar[XB_TMO])) break; if (sp > XB_SPIN_CAP) { atomicAdd(&bar[XB_TMO], 1u); break; } }
    }
    nloc = mine > 0u ? mine : 1u; nx = cnt > 0u ? cnt : 1u;
}

__device__ __forceinline__ void xcd_barrier(const XcdBarrier& b) {
    asm volatile("s_waitcnt vmcnt(0)" ::: "memory");
    __syncthreads();
    if (threadIdx.x == 0) {
        unsigned* bar = b.bar;
        __builtin_amdgcn_s_waitcnt(0);
        unsigned nloc = b.st[0], nx = b.st[1];
        if (nloc == 0u) { xcd_barrier_complete(bar, b.x, nloc, nx); b.st[0] = nloc; b.st[1] = nx; }
        const unsigned old = xb_add(&bar[XB_XSUB(b.x)], 1u);
        const unsigned gen = old / nloc;
        if (old + 1u == (gen + 1u) * nloc) {
            __builtin_amdgcn_fence(__ATOMIC_RELEASE, "agent");
            asm volatile("s_waitcnt vmcnt(0)" ::: "memory");
            const unsigned og = xb_add(&bar[XB_TOP], 1u);
            const unsigned tg = og / nx;
            if (og + 1u == (tg + 1u) * nx) xb_add(&bar[XB_TOPGEN], 1u);
            else XB_SPIN(xb_ld(&bar[XB_TOPGEN]) == tg, bar);
            __builtin_amdgcn_fence(__ATOMIC_ACQUIRE, "agent");
            xb_add(&bar[XB_XGEN(b.x)], 1u);
            asm volatile("s_waitcnt vmcnt(0)" ::: "memory");
        } else {
            XB_SPIN(xb_ld(&bar[XB_XGEN(b.x)]) == gen, bar);
            __builtin_amdgcn_fence(__ATOMIC_ACQUIRE, "agent");
            asm volatile("s_waitcnt vmcnt(0)" ::: "memory");
        }
    }
    __syncthreads();
}


#ifndef STOP_AFTER
#define STOP_AFTER 0
#endif
__global__ void __launch_bounds__(512, 2) mega_fwd(Args a_unused) {
#define kp (kargs_fresh())
    extern __shared__ __attribute__((aligned(16))) unsigned char lds_raw[];
    LAS unsigned char* lds = (LAS unsigned char*)lds_raw;
    if (threadIdx.x < 64) ((LAS unsigned*)(lds + LDS_CTL))[threadIdx.x] = 0u;
    __syncthreads();
    XcdBarrier xbar = xcd_barrier_post((unsigned*)(karg_ws(kargs_fresh()) + WS_CTL), (volatile LAS unsigned*)(lds + LDS_CTL));
    const int G = gridDim.x, bx = blockIdx.x, vcu = (G % 8 == 0) ? (bx % 8) * (G / 8) + bx / 8 : bx;
#define ws (karg_ws(kargs_fresh()))
#define mod ((const float*)(ws + WS_MOD))
#define gmv ((const float*)(ws + WS_GM))
#define bvec ((const float*)(ws + WS_BV))
#define rowss ((float*)(ws + WS_ROWSS))
#define AP ((bf16_t*)(ws + WS_AP))
#define PROJ ((bf16_t*)(ws + WS_PROJ))
#define CAT ((bf16_t*)(ws + WS_CAT))
#ifdef NO_GEMM
#define GEMM_PHASE(EPI, Aptr, Bptr, N_, K_, E_) do {} while (0)
#else
#define GEMM_PHASE(EPI, Aptr, Bptr, N_, K_, E_) do { int gG_ = G, gbx_ = bx; asm volatile("" : "+s"(gG_), "+s"(gbx_));     \
        pg8::Gemm g_{(const pg8::bf16_t*)(Aptr), (const pg8::bf16_t*)(Bptr), L, (N_), (K_)}; pg8::StaticOrder S_; S_.init(L, (N_), gG_, gbx_); \
        pg8::gemm_phase<EPI, pg8::StaticOrder, true, true>(lds, g_, S_, E_); } while (0)
#endif

#ifndef NO_P0
    phase_p0a(kargs_fresh(), lds, vcu, G); GSYNC();
    phase_p0b(kargs_fresh(), vcu, G); GSYNC();
    phase_p0c(kargs_fresh(), vcu, G); GSYNC();
#endif
#ifdef DUMP_WS_BF16
    { const int gid_ = vcu * 512 + tid_opaque(); for (size_t i = gid_; i < (size_t)L * 1024; i += (size_t)G * 512) karg_out(kp)[i] = bf1(((const bf16_t*)(ws + (size_t)(DUMP_WS_BF16)))[i % (size_t)(DUMP_N)]); return; }
#endif
#ifdef DUMP_WS_F32
    { const int gid_ = vcu * 512 + tid_opaque(); for (size_t i = gid_; i < (size_t)L * 1024; i += (size_t)G * 512) karg_out(kp)[i] = ((const float*)(ws + (size_t)(DUMP_WS_F32)))[i % (size_t)(DUMP_N)]; return; }
#endif
#define modl (mod + layer * 6144)
    {
        constexpr int layer = 0;
            { pg8::EpiProj E{PROJ, EV_IN, bvec, rowss, 0xC3u}; if (EN_PROJ) GEMM_PHASE(pg8::EpiProj, AP, ws + WS_WEVIN, EV_IN, 1024, E); }
            GSYNC();
#ifndef NO_ATTN
            phase_attn(kargs_fresh(), lds, vcu, G);
#ifdef TIME_DUP_ATTN
            GSYNC(); phase_attn(kargs_fresh(), lds, vcu, G);
#endif
#endif
            GSYNC();
#ifdef DUMP_CAT
            { const int gid_ = vcu * 512 + tid_opaque(); for (size_t i = gid_; i < (size_t)L * 1024; i += (size_t)G * 512) karg_out(kp)[i] = bf1(CAT[i]); return; }
#endif
#ifdef DUMP_PROJ
            { const int gid_ = vcu * 512 + tid_opaque(); for (size_t i = gid_; i < (size_t)L * 1024; i += (size_t)G * 512) { const size_t r = i >> 10, c = i & 1023; karg_out(kp)[i] = bf1(PROJ[r * 3072 + (DUMP_PROJ) * 1024 + c]); } return; }
#endif
            { pg8::EpiRes E{karg_in(kp, I_X), karg_out(kp), modl + 2048, gmv + 1024, AP, rowss + (size_t)L * 16}; if (EN_RES1) GEMM_PHASE(pg8::EpiRes, CAT, ws + WS_WEVOUT, 1024, 1024, E); }
            GSYNC();
#ifdef DUP_EVOUT_1
            { pg8::EpiRes E{karg_in(kp, I_X), karg_out(kp), mod + 2048, gmv + 1024, AP, rowss + (size_t)L * 16}; GEMM_PHASE(pg8::EpiRes, CAT, ws + WS_WEVOUT, 1024, 1024, E); }
            GSYNC();
#endif
#if STOP_AFTER == 1
            return;
#endif
        { pg8::EpiFfn E{PROJ, bvec + 5120 + layer * 5632, rowss + (size_t)(layer ? 3 : 1) * L * 16, karg_in(kp, I_CONVW) + (size_t)layer * 3 * 2816, karg_in(kp, I_CONVB) + (size_t)layer * 2816,
                        (float*)(ws + WS_HEADV), (float*)(ws + WS_HEADG), (float*)(ws + WS_TAILG), (LAS float*)(lds + LDS_XG)};
          if (EN_FFN) GEMM_PHASE(pg8::EpiFfn, AP, ws + WS_WFFIN + layer * WFFIN_STRIDE, 5632, 1024, E); }
        GSYNC();
#ifdef DUP_EVOUT_FFNIN
        { pg8::EpiRes E{karg_in(kp, I_X), karg_out(kp), mod + 2048, gmv + 1024, AP, rowss + (size_t)L * 16}; GEMM_PHASE(pg8::EpiRes, CAT, ws + WS_WEVOUT, 1024, 1024, E); }
        GSYNC();
        return;
#endif
        { pg8::StaticOrder S0; S0.init(L, 1024, G, bx); pg8::Unit u0; for (int i = 0; S0.next(i, u0); ++i) ffn_fixup(kargs_fresh(), layer, u0.pm);
          pg8::EpiRes E{karg_out(kp), karg_out(kp), modl + 5120, layer ? nullptr : gmv + 2048, AP, rowss + (size_t)(layer ? 4 : 2) * L * 16}; if (EN_RES3) GEMM_PHASE(pg8::EpiRes, PROJ, ws + WS_WFFOUT + layer * WFFOUT_STRIDE, 1024, 2816, E); }
        GSYNC();
#if STOP_AFTER == 2
        if (layer == 0) {
#ifdef PRE_SYNCS
            for (int q = 0; q < PRE_SYNCS; ++q) GSYNC();
#endif
#ifdef DUP_AFTER_FFNOUT
            { pg8::EpiRes E{karg_in(kp, I_X), karg_out(kp), mod + 2048, gmv + 1024, AP, rowss + (size_t)L * 16}; GEMM_PHASE(pg8::EpiRes, CAT, ws + WS_WEVOUT, 1024, 1024, E); }
            GSYNC();
#endif
#ifdef EXTRA_SYNCS
            for (int q = 0; q < EXTRA_SYNCS; ++q) GSYNC();
#endif
#ifdef END_DUMP_BF16
            { const int gid_ = vcu * 512 + tid_opaque(); for (size_t i = gid_; i < (size_t)L * 1024; i += (size_t)G * 512) karg_out(kp)[i] = bf1(((const bf16_t*)(ws + (size_t)(END_DUMP_BF16)))[i % (size_t)(DUMP_N)]); }
#endif
#ifdef END_DUMP_F32
            { const int gid_ = vcu * 512 + tid_opaque(); for (size_t i = gid_; i < (size_t)L * 1024; i += (size_t)G * 512) karg_out(kp)[i] = ((const float*)(ws + (size_t)(END_DUMP_F32)))[i % (size_t)(DUMP_N)]; }
#endif
            return; }
#endif
    }
    {
        constexpr int layer = 1;
            { pg8::EpiRope E{PROJ, OD_IN, bvec + 3072, rowss + (size_t)2 * L * 16, (const float*)(ws + WS_ROPE)}; if (EN_ROPE) GEMM_PHASE(pg8::EpiRope, AP, ws + WS_WODIN, OD_IN, 1024, E); }
            GSYNC();
#if !defined(NO_RET) && !defined(NO_RET1)
            phase_ret1(kargs_fresh(), lds, vcu, G);
#endif
#ifndef NO_S5
            phase_s5<false>(kargs_fresh(), lds, vcu, G);
#endif
            GSYNC();
#ifndef NO_SCAN
            phase_scans(kargs_fresh(), vcu, G);
#endif
            GSYNC();
#if !defined(NO_RET) && !defined(NO_RET2)
            phase_ret2(kargs_fresh(), lds, vcu, G);
#endif
#ifndef NO_S5
            phase_s5<true>(kargs_fresh(), lds, vcu, G);
#endif
#ifdef TIME_DUP_ODD
            GSYNC(); phase_ret1(kargs_fresh(), lds, vcu, G); phase_s5<false>(kargs_fresh(), lds, vcu, G); GSYNC(); phase_scans(kargs_fresh(), vcu, G); GSYNC(); phase_ret2(kargs_fresh(), lds, vcu, G); phase_s5<true>(kargs_fresh(), lds, vcu, G);
#endif
#ifdef TIME_EXTRA_SYNCS
            for (int q_ = 0; q_ < TIME_EXTRA_SYNCS; ++q_) GSYNC();
#endif
            GSYNC();
            { pg8::EpiGlu E{CAT, 1024, 512}; if (EN_GLU) GEMM_PHASE(pg8::EpiGlu, ws + WS_YG, ws + WS_WGLU, 1024, 512, E); }
            GSYNC();
            { pg8::EpiRes E{karg_out(kp), karg_out(kp), modl + 2048, gmv + 3072, AP, rowss + (size_t)3 * L * 16}; if (EN_RES2) GEMM_PHASE(pg8::EpiRes, CAT, ws + WS_WODOUT, 1024, 1024, E); }
            GSYNC();
#if STOP_AFTER == 3
            return;
#endif
        { pg8::EpiFfn E{PROJ, bvec + 5120 + layer * 5632, rowss + (size_t)(layer ? 3 : 1) * L * 16, karg_in(kp, I_CONVW) + (size_t)layer * 3 * 2816, karg_in(kp, I_CONVB) + (size_t)layer * 2816,
                        (float*)(ws + WS_HEADV), (float*)(ws + WS_HEADG), (float*)(ws + WS_TAILG), (LAS float*)(lds + LDS_XG)};
          if (EN_FFN) GEMM_PHASE(pg8::EpiFfn, AP, ws + WS_WFFIN + layer * WFFIN_STRIDE, 5632, 1024, E); }
        GSYNC();
#ifdef DUP_EVOUT_FFNIN
        { pg8::EpiRes E{karg_in(kp, I_X), karg_out(kp), mod + 2048, gmv + 1024, AP, rowss + (size_t)L * 16}; GEMM_PHASE(pg8::EpiRes, CAT, ws + WS_WEVOUT, 1024, 1024, E); }
        GSYNC();
        return;
#endif
        { pg8::StaticOrder S0; S0.init(L, 1024, G, bx); pg8::Unit u0; for (int i = 0; S0.next(i, u0); ++i) ffn_fixup(kargs_fresh(), layer, u0.pm);
          pg8::EpiRes E{karg_out(kp), karg_out(kp), modl + 5120, layer ? nullptr : gmv + 2048, AP, rowss + (size_t)(layer ? 4 : 2) * L * 16}; if (EN_RES3) GEMM_PHASE(pg8::EpiRes, PROJ, ws + WS_WFFOUT + layer * WFFOUT_STRIDE, 1024, 2816, E); }
        GSYNC();
#if STOP_AFTER == 2
        if (layer == 0) {
#ifdef PRE_SYNCS
            for (int q = 0; q < PRE_SYNCS; ++q) GSYNC();
#endif
#ifdef DUP_AFTER_FFNOUT
            { pg8::EpiRes E{karg_in(kp, I_X), karg_out(kp), mod + 2048, gmv + 1024, AP, rowss + (size_t)L * 16}; GEMM_PHASE(pg8::EpiRes, CAT, ws + WS_WEVOUT, 1024, 1024, E); }
            GSYNC();
#endif
#ifdef EXTRA_SYNCS
            for (int q = 0; q < EXTRA_SYNCS; ++q) GSYNC();
#endif
#ifdef END_DUMP_BF16
            { const int gid_ = vcu * 512 + tid_opaque(); for (size_t i = gid_; i < (size_t)L * 1024; i += (size_t)G * 512) karg_out(kp)[i] = bf1(((const bf16_t*)(ws + (size_t)(END_DUMP_BF16)))[i % (size_t)(DUMP_N)]); }
#endif
#ifdef END_DUMP_F32
            { const int gid_ = vcu * 512 + tid_opaque(); for (size_t i = gid_; i < (size_t)L * 1024; i += (size_t)G * 512) karg_out(kp)[i] = ((const float*)(ws + (size_t)(END_DUMP_F32)))[i % (size_t)(DUMP_N)]; }
#endif
            return; }
#endif
    }
    phase_final(kargs_fresh(), vcu, G);
#undef ws
#undef mod
#undef gmv
#undef bvec
#undef rowss
#undef AP
#undef PROJ
#undef CAT
#undef modl
#undef kp
}
extern "C" void kernel_launch(void* const* d_in, const int* in_sizes, int n_in, void* d_out, int out_size, void* d_ws, size_t ws_size, hipStream_t stream) {
    static int grid = 0;
    if (grid == 0) {
        if (n_in != 28 || out_size != L * DM || ws_size < WS_END) { fprintf(stderr, "kernel_launch: unexpected problem (n_in %d out %d ws %zu)\n", n_in, out_size, ws_size); grid = -1; return; }
        int dev = 0, cus = 0, per_cu = 0;
        hipGetDevice(&dev); hipDeviceGetAttribute(&cus, hipDeviceAttributeMultiprocessorCount, dev);
        hipFuncSetAttribute((const void*)mega_fwd, hipFuncAttributeMaxDynamicSharedMemorySize, LDS_BYTES);
        hipOccupancyMaxActiveBlocksPerMultiprocessor(&per_cu, (const void*)mega_fwd, 512, LDS_BYTES);
        (void)hipGetLastError();
        if (per_cu < 1) { fprintf(stderr, "kernel_launch: occupancy query says %d blocks per CU\n", per_cu); per_cu = 1; }
        grid = cus;
    }
    if (grid < 0) return;
    Args a{};
    for (int i = 0; i < 28; ++i) a.in[i] = (const float*)d_in[i];
    a.out = (float*)d_out; a.ws = (unsigned char*)d_ws;
    if (hipMemsetAsync((char*)d_ws + WS_CTL, 0, CTL_BYTES, stream) != hipSuccess) { fprintf(stderr, "kernel_launch: hipMemsetAsync failed\n"); return; }
    void* args[] = {&a};
    hipError_t e = hipLaunchCooperativeKernel((void*)mega_fwd, dim3(grid), dim3(512), args, LDS_BYTES, stream);
    if (e != hipSuccess) fprintf(stderr, "cooperative launch failed: %s (grid %d)\n", hipGetErrorString(e), grid);
}
```

```cpp
#include <hip/hip_runtime.h>
#include <hip/hip_cooperative_groups.h>
#include <cstdio>
#include <cstdint>
namespace cg = cooperative_groups;
__device__ __forceinline__ int tid_opaque() { int t = threadIdx.x; asm volatile("" : "+v"(t)); return t; }
namespace pg8 {
#define PG8_LAS __attribute__((address_space(3)))
typedef unsigned short bf16_t;
typedef short bf16x8 __attribute__((ext_vector_type(8)));
typedef float f32x4 __attribute__((ext_vector_type(4)));
typedef unsigned u32x4 __attribute__((ext_vector_type(4)));
constexpr int BM = 256, BK = 64, HALF = 128, HTB = HALF * BK * 2  , STAGE_BYTES = 8 * HTB, NXCD = 8, WGM = 8;

__host__ __device__ __forceinline__ int lds_byte(int r, int c) { const int st = (r >> 4) * 2 + (c >> 5), rr = r & 15, cc = c & 31, ob = rr * 64 + cc * 2; return st * 1024 + (ob ^ (((ob >> 9) & 1) << 5)); }
__host__ __device__ __forceinline__ void stage_rc(int b, int& R, int& C) { const int st = b / 1024, sb = b % 1024, swz = sb ^ (((sb >> 9) & 1) << 5); R = (st >> 1) * 16 + swz / 64; C = (st & 1) * 32 + (swz % 64) / 2; }
__host__ __device__ __forceinline__ int perm32(int rho) { const int n = rho >> 4, i = rho & 15; return 8 * (i >> 2) + 4 * n + (i & 3); }

struct Unit { int pm, pn; };
struct Gemm { const bf16_t* A; const bf16_t* Bt; int M, N, K; };

struct StaticOrder {
    int nM, nN, nwg, G, c;
    __host__ __device__ __forceinline__ void init(int M, int N, int G_, int c_) { nM = M / BM; nN = N / BM; nwg = nM * nN; G = G_; c = c_; }
    __host__ __device__ __forceinline__ bool next(int i, Unit& u) const {
        const long L = (long)i * G + c; if (L >= nwg) return false;
        int wgid = (int)L; { const int q = nwg / NXCD, r = nwg % NXCD, xcd = wgid % NXCD, off = wgid / NXCD; wgid = (xcd < r ? xcd * (q + 1) : r * (q + 1) + (xcd - r) * q) + off; }
        const int nig = WGM * nN, gid = wgid / nig, fm = gid * WGM, gsz = (nM - fm) < WGM ? (nM - fm) : WGM;
        u.pm = fm + ((wgid % nig) % gsz); u.pn = (wgid % nig) / gsz; return true;
    }
    __device__ __forceinline__ void a_ready(const Unit&) const {}
    __device__ __forceinline__ void done(const Unit&) const {}
};

__device__ __forceinline__ unsigned cvt_pk_bf16(float lo, float hi) { unsigned r; asm volatile("v_cvt_pk_bf16_f32 %0, %1, %2" : "=v"(r) : "v"(lo), "v"(hi)); return r; }
typedef float f32x2 __attribute__((ext_vector_type(2)));
constexpr float RMS_EPS = 1e-6f;
constexpr float C2Q = 0.125f * 1.4426950408889634f;
typedef unsigned u32x2 __attribute__((ext_vector_type(2)));
__device__ __forceinline__ float fast_sigmoid(float x) { return __builtin_amdgcn_rcpf(1.0f + __builtin_amdgcn_exp2f(-1.4426950408889634f * x)); }
__device__ __forceinline__ float gelu_tanh(float x) { const float u = 0.7978845608028654f * (x + 0.044715f * x * x * x); return x * __builtin_amdgcn_rcpf(1.0f + __builtin_amdgcn_exp2f(-2.8853900817779268f * u)); }
__device__ __forceinline__ float rs_of(const float* p16, int fq) { const f32x4 a = *(const f32x4*)(p16 + 4 * fq);
    float ss = (a[0] + a[1]) + (a[2] + a[3]); ss += __shfl_xor(ss, 16); ss += __shfl_xor(ss, 32);
    return 1.0f / sqrtf(ss * (1.0f / 1024.0f) + RMS_EPS); }
struct EpiProj {
    static constexpr bool PERM = true, AFTER_DRAIN = false;
    bf16_t* O; int ldc; const float* bv; const float* rowss; unsigned qmask;
    __device__ __forceinline__ void operator()(const f32x4 (&acc)[2][2][4][2], const Unit& u, int wr, int wc, int fr, int fq) const {
        const int row0 = u.pm * BM + wr * 64 + fr, col0 = u.pn * BM + wc * 32 + 8 * fq;
        const float sc = ((qmask >> u.pn) & 1u) ? C2Q : 1.0f;
        f32x4 bvv[2][2];
#pragma unroll
        for (int bj = 0; bj < 2; ++bj)
#pragma unroll
            for (int n = 0; n < 2; ++n) bvv[bj][n] = *(const f32x4*)(bv + col0 + bj * HALF + 4 * n);
#pragma unroll
        for (int ai = 0; ai < 2; ++ai)
#pragma unroll
            for (int m = 0; m < 4; ++m) { const int row = row0 + ai * HALF + m * 16; const float rs = rs_of(rowss + (size_t)row * 16, fq); bf16_t* rowp = O + (size_t)row * ldc + col0;
#pragma unroll
                for (int bj = 0; bj < 2; ++bj) { const f32x4 v0 = (acc[ai][bj][m][0] * rs + bvv[bj][0]) * sc, v1 = (acc[ai][bj][m][1] * rs + bvv[bj][1]) * sc;
                    u32x4 w; w.x = cvt_pk_bf16(v0[0], v0[1]); w.y = cvt_pk_bf16(v0[2], v0[3]); w.z = cvt_pk_bf16(v1[0], v1[1]); w.w = cvt_pk_bf16(v1[2], v1[3]);
                    *(u32x4*)(rowp + bj * HALF) = w; } }
    }
};
struct EpiRope {
    static constexpr bool PERM = true, AFTER_DRAIN = false;
    bf16_t* O; int ldc; const float* bv; const float* rowss; const float* rope;
    __device__ __forceinline__ void operator()(const f32x4 (&acc)[2][2][4][2], const Unit& u, int wr, int wc, int fr, int fq) const {
        const int row0 = u.pm * BM + wr * 64 + fr, col0 = u.pn * BM + wc * 32 + 8 * fq;
        const bool rot = u.pn < 2; const float sc = (u.pn == 1) ? 0.125f : 1.0f;
        const int i0 = 16 * (wc & 1) + 4 * fq;
        f32x4 bvv[2][2];
#pragma unroll
        for (int bj = 0; bj < 2; ++bj)
#pragma unroll
            for (int n = 0; n < 2; ++n) bvv[bj][n] = *(const f32x4*)(bv + col0 + bj * HALF + 4 * n);
#pragma unroll
        for (int ai = 0; ai < 2; ++ai)
#pragma unroll
            for (int m = 0; m < 4; ++m) { const int row = row0 + ai * HALF + m * 16; const float rs = rs_of(rowss + (size_t)row * 16, fq); bf16_t* rowp = O + (size_t)row * ldc + col0;
                f32x4 cs0 = (f32x4){1.f, 0.f, 1.f, 0.f}, cs1 = cs0;
                if (rot) { const f32x4* rp = (const f32x4*)(rope + ((size_t)row * 32 + i0) * 2); cs0 = rp[0]; cs1 = rp[1]; }
#pragma unroll
                for (int bj = 0; bj < 2; ++bj) { f32x4 v0 = acc[ai][bj][m][0] * rs + bvv[bj][0], v1 = acc[ai][bj][m][1] * rs + bvv[bj][1];
                    if (rot) {
                        f32x4 r0, r1;
                        r0[0] = v0[0] * cs0[0] - v0[1] * cs0[1]; r0[1] = v0[0] * cs0[1] + v0[1] * cs0[0];
                        r0[2] = v0[2] * cs0[2] - v0[3] * cs0[3]; r0[3] = v0[2] * cs0[3] + v0[3] * cs0[2];
                        r1[0] = v1[0] * cs1[0] - v1[1] * cs1[1]; r1[1] = v1[0] * cs1[1] + v1[1] * cs1[0];
                        r1[2] = v1[2] * cs1[2] - v1[3] * cs1[3]; r1[3] = v1[2] * cs1[3] + v1[3] * cs1[2];
                        v0 = r0 * sc; v1 = r1 * sc; }
                    u32x4 w; w.x = cvt_pk_bf16(v0[0], v0[1]); w.y = cvt_pk_bf16(v0[2], v0[3]); w.z = cvt_pk_bf16(v1[0], v1[1]); w.w = cvt_pk_bf16(v1[2], v1[3]);
                    *(u32x4*)(rowp + bj * HALF) = w; } }
    }
};
struct EpiRes {
    static constexpr bool PERM = true, AFTER_DRAIN = false;
    const float* xin; float* xout; const float* gate; const float* gm; bf16_t* AP; float* rowss;
    __device__ __forceinline__ void operator()(const f32x4 (&acc)[2][2][4][2], const Unit& u, int wr, int wc, int fr, int fq) const {
        const int row0 = u.pm * BM + wr * 64 + fr, col0 = u.pn * BM + wc * 32 + 8 * fq;
        f32x4 gv[2][2], gmv[2][2];
#pragma unroll
        for (int bj = 0; bj < 2; ++bj)
#pragma unroll
            for (int n = 0; n < 2; ++n) { gv[bj][n] = *(const f32x4*)(gate + col0 + bj * HALF + 4 * n); gmv[bj][n] = gm ? *(const f32x4*)(gm + col0 + bj * HALF + 4 * n) : (f32x4){0.f, 0.f, 0.f, 0.f}; }
#pragma unroll
        for (int ai = 0; ai < 2; ++ai)
#pragma unroll
            for (int m = 0; m < 4; ++m) { const int row = row0 + ai * HALF + m * 16; const size_t off = (size_t)row * 1024 + col0; float ss = 0.f;
#pragma unroll
                for (int bj = 0; bj < 2; ++bj) {
                    const f32x4 x0 = *(const f32x4*)(xin + off + bj * HALF) + gv[bj][0] * acc[ai][bj][m][0];
                    const f32x4 x1 = *(const f32x4*)(xin + off + bj * HALF + 4) + gv[bj][1] * acc[ai][bj][m][1];
                    *(f32x4*)(xout + off + bj * HALF) = x0; *(f32x4*)(xout + off + bj * HALF + 4) = x1;
                    ss += (x0[0] * x0[0] + x0[1] * x0[1]) + (x0[2] * x0[2] + x0[3] * x0[3]) + (x1[0] * x1[0] + x1[1] * x1[1]) + (x1[2] * x1[2] + x1[3] * x1[3]);
                    if (gm) { const f32x4 a0 = x0 * gmv[bj][0], a1 = x1 * gmv[bj][1];
                        u32x4 w; w.x = cvt_pk_bf16(a0[0], a0[1]); w.y = cvt_pk_bf16(a0[2], a0[3]); w.z = cvt_pk_bf16(a1[0], a1[1]); w.w = cvt_pk_bf16(a1[2], a1[3]);
                        *(u32x4*)(AP + off + bj * HALF) = w; } }
                ss += __shfl_xor(ss, 16); ss += __shfl_xor(ss, 32);
                if (fq == 0) rowss[(size_t)row * 16 + u.pn * 4 + wc] = ss; }
    }
};
struct EpiGlu {
    static constexpr bool PERM = true, AFTER_DRAIN = false;
    bf16_t* O; int ldc; int ocol0;
    __device__ __forceinline__ void operator()(const f32x4 (&acc)[2][2][4][2], const Unit& u, int wr, int wc, int fr, int fq) const {
        const int row0 = u.pm * BM + wr * 64 + fr, col0 = ocol0 + u.pn * HALF + wc * 32 + 8 * fq;
#pragma unroll
        for (int ai = 0; ai < 2; ++ai)
#pragma unroll
            for (int m = 0; m < 4; ++m) { const int row = row0 + ai * HALF + m * 16;
                f32x4 y0, y1;
#pragma unroll
                for (int j = 0; j < 4; ++j) { y0[j] = acc[ai][0][m][0][j] * fast_sigmoid(acc[ai][1][m][0][j]); y1[j] = acc[ai][0][m][1][j] * fast_sigmoid(acc[ai][1][m][1][j]); }
                u32x4 w; w.x = cvt_pk_bf16(y0[0], y0[1]); w.y = cvt_pk_bf16(y0[2], y0[3]); w.z = cvt_pk_bf16(y1[0], y1[1]); w.w = cvt_pk_bf16(y1[2], y1[3]);
                *(u32x4*)(O + (size_t)row * ldc + col0) = w; }
    }
};
struct EpiFfn {
    static constexpr bool PERM = true, AFTER_DRAIN = false;
    bf16_t* ACT; const float* bv; const float* rowss; const float* cw; const float* cb; float* headv; float* headg; float* tailg; PG8_LAS float* xg;
    __device__ __forceinline__ void operator()(const f32x4 (&acc)[2][2][4][2], const Unit& u, int wr, int wc, int fr, int fq) const {
        const int lane = (fq << 4) | fr;
        const int lc = wc * 32 + 8 * fq, f0 = u.pn * HALF + lc, pc0 = u.pn * BM + lc;
        float rs[2][4];
#pragma unroll
        for (int ai = 0; ai < 2; ++ai)
#pragma unroll
            for (int m = 0; m < 4; ++m) rs[ai][m] = rs_of(rowss + (size_t)(u.pm * BM + ai * HALF + wr * 64 + m * 16 + fr) * 16, fq);
        if (fr >= 14) {
#pragma unroll
            for (int n = 0; n < 2; ++n) { const f32x4 bvg = *(const f32x4*)(bv + pc0 + HALF + 4 * n);
#pragma unroll
                for (int ai = 0; ai < 2; ++ai) { const f32x4 g3 = acc[ai][1][3][n] * rs[ai][3] + bvg;
                    *(PG8_LAS f32x4*)(xg + ((2 * ai + wr) * 2 + (fr - 14)) * 128 + lc + 4 * n) = g3;
                    if (ai == 1 && wr == 1) *(f32x4*)(tailg + (size_t)(u.pm * 2 + (fr - 14)) * 2816 + f0 + 4 * n) = g3; } }
        }
        asm volatile("s_waitcnt lgkmcnt(0)" ::: "memory"); __builtin_amdgcn_s_barrier(); asm volatile("" ::: "memory");
        const int src1 = (lane & 48) | ((fr + 15) & 15), src2 = (lane & 48) | ((fr + 14) & 15);
        u32x2 pk0[2][4];
#pragma unroll
        for (int n = 0; n < 2; ++n) {
            const f32x4 w0 = *(const f32x4*)(cw + f0 + 4 * n), w1 = *(const f32x4*)(cw + 2816 + f0 + 4 * n), w2 = *(const f32x4*)(cw + 5632 + f0 + 4 * n), cbv = *(const f32x4*)(cb + f0 + 4 * n);
            const f32x4 bvv = *(const f32x4*)(bv + pc0 + 4 * n), bvg = *(const f32x4*)(bv + pc0 + HALF + 4 * n);
#pragma unroll
            for (int ai = 0; ai < 2; ++ai) {
                const int b = 2 * ai + wr;
                f32x4 P1 = (f32x4){0.f, 0.f, 0.f, 0.f}, P2 = P1;
                if (b >= 1) { P2 = *(const PG8_LAS f32x4*)(xg + ((b - 1) * 2 + 0) * 128 + lc + 4 * n); P1 = *(const PG8_LAS f32x4*)(xg + ((b - 1) * 2 + 1) * 128 + lc + 4 * n); }
                f32x4 s1p = P1, s2p = (fr == 1) ? P1 : P2;
#pragma unroll
                for (int m = 0; m < 4; ++m) {
                    const int row = u.pm * BM + ai * HALF + wr * 64 + m * 16 + fr;
                    const bool head = (b == 0) && (m == 0) && (fr < 2) && (u.pm > 0);
                    const f32x4 g = acc[ai][1][m][n] * rs[ai][m] + bvg;
                    const f32x4 val = acc[ai][0][m][n] * rs[ai][m] + bvv;
                    f32x4 s1, s2;
#pragma unroll
                    for (int j = 0; j < 4; ++j) { s1[j] = __shfl(g[j], src1); s2[j] = __shfl(g[j], src2); }
                    const f32x4 p1 = (fr >= 1) ? s1 : s1p, p2 = (fr >= 2) ? s2 : s2p;
                    s1p = s1; s2p = s2;
                    const f32x4 cv = w0 * p2 + w1 * p1 + w2 * g + cbv;
                    f32x4 av;
#pragma unroll
                    for (int j = 0; j < 4; ++j) av[j] = gelu_tanh(cv[j]) * val[j];
                    if (head) { *(f32x4*)(headv + (size_t)(u.pm * 2 + fr) * 2816 + f0 + 4 * n) = val; *(f32x4*)(headg + (size_t)(u.pm * 2 + fr) * 2816 + f0 + 4 * n) = g; }
                    const u32x2 pk = (u32x2){cvt_pk_bf16(av[0], av[1]), cvt_pk_bf16(av[2], av[3])};
                    if (n == 0) pk0[ai][m] = pk;
                    else if (!head) { u32x4 w; w.x = pk0[ai][m].x; w.y = pk0[ai][m].y; w.z = pk.x; w.w = pk.y; *(u32x4*)(ACT + (size_t)row * 2816 + f0) = w; }
                }
            }
        }
    }
};
template <class Epi, class Sched, bool ALIGN_EPI = false, bool SP2 = false>
__device__ __forceinline__ void gemm_phase(PG8_LAS unsigned char* lds, const Gemm g, const Sched& S, const Epi& E) {
    const int tid = tid_opaque(), wid = __builtin_amdgcn_readfirstlane(tid >> 6), lane = tid & 63, wr = wid >> 2, wc = wid & 3, fr = lane & 15, fq = lane >> 4;
    const int K = g.K, nt = K / BK;
    unsigned voffA[2], voffB[2];
#pragma unroll
    for (int i = 0; i < 2; ++i) { int R, C; stage_rc(tid * 16 + i * 8192, R, C); const int Rb = Epi::PERM ? ((R & ~31) + perm32(R & 31)) : R;
        voffA[i] = (unsigned)(R * K + C) * 2u; voffB[i] = (unsigned)(Rb * K + C) * 2u; }
    const size_t kstep = (size_t)(BK * 2);
    const size_t hstep = (size_t)HALF * K * 2;
    const size_t tstep = 2 * hstep;
    const unsigned ldsw = (unsigned)wid * 1024u;
    const int aoff = lds_byte(wr * 64 + fr, fq * 8), boff = lds_byte(wc * 32 + fr, fq * 8);
#define PG8_SA(b, h) (((b) * 2 + (h)) * HTB)
#define PG8_SB(b, h) ((4 + (b) * 2 + (h)) * HTB)
#define PG8_STAGE(bufoff, gbase, voff) do { _Pragma("unroll") for (int _i = 0; _i < 2; ++_i) { unsigned _vo = (voff)[_i]; asm volatile("" : "+v"(_vo)); \
        __builtin_amdgcn_global_load_lds((const unsigned*)((const char*)(gbase) + _vo), (PG8_LAS unsigned*)(lds + (bufoff) + ldsw + _i * 8192), 16, 0, 0); } } while (0)
#define PG8_LDA(dst, b, h) do { _Pragma("unroll") for (int m = 0; m < 4; ++m) _Pragma("unroll") for (int k = 0; k < 2; ++k) dst[m][k] = *(const PG8_LAS bf16x8*)(lds + PG8_SA(b, h) + aoff + m * 2048 + k * 1024); } while (0)
#define PG8_LDB(dst, b, h) do { _Pragma("unroll") for (int n = 0; n < 2; ++n) _Pragma("unroll") for (int k = 0; k < 2; ++k) dst[n][k] = *(const PG8_LAS bf16x8*)(lds + PG8_SB(b, h) + boff + n * 2048 + k * 1024); } while (0)
#define PG8_MMA(ai, bj, At, Bt) do { __builtin_amdgcn_s_setprio(1); _Pragma("unroll") for (int m = 0; m < 4; ++m) _Pragma("unroll") for (int n = 0; n < 2; ++n) _Pragma("unroll") for (int k = 0; k < 2; ++k) \
        acc[ai][bj][m][n] = __builtin_amdgcn_mfma_f32_16x16x32_bf16(Bt[n][k], At[m][k], acc[ai][bj][m][n], 0, 0, 0); __builtin_amdgcn_s_setprio(0); } while (0)
#define PG8_WAIT_V(n) asm volatile("s_waitcnt vmcnt(" #n ")" ::: "memory")
#define PG8_WAIT_L(n) asm volatile("s_waitcnt lgkmcnt(" #n ")" ::: "memory")
#define PG8_BAR do { asm volatile("" ::: "memory"); __builtin_amdgcn_s_barrier(); asm volatile("" ::: "memory"); } while (0)
#define PG8_SCHED __builtin_amdgcn_sched_barrier(0)
    Unit cur, nxt; int ui = 0;
    if (!S.next(0, cur)) return;
    f32x4 acc[2][2][4][2];
#pragma unroll
    for (int a = 0; a < 2; ++a)
#pragma unroll
        for (int b = 0; b < 2; ++b)
#pragma unroll
            for (int m = 0; m < 4; ++m)
#pragma unroll
                for (int n = 0; n < 2; ++n) acc[a][b][m][n] = (f32x4){0.f, 0.f, 0.f, 0.f};
    bf16x8 At[4][2], B0[2][2], B1[2][2];
    const char* cA = (const char*)g.A + (size_t)cur.pm * tstep; const char* cB = (const char*)g.Bt + (size_t)cur.pn * tstep;
    S.a_ready(cur);
    if constexpr (SP2) {
        PG8_STAGE(PG8_SB(0, 0), cB, voffB); PG8_STAGE(PG8_SB(0, 1), cB + hstep, voffB); PG8_STAGE(PG8_SA(0, 0), cA, voffA); PG8_STAGE(PG8_SA(0, 1), cA + hstep, voffA);
        if (wr == 1) PG8_BAR;
        PG8_WAIT_V(2); PG8_BAR;
        PG8_STAGE(PG8_SB(1, 0), cB + kstep, voffB); PG8_STAGE(PG8_SA(1, 0), cA + kstep, voffA); PG8_STAGE(PG8_SB(1, 1), cB + hstep + kstep, voffB);
        PG8_WAIT_V(6); PG8_BAR;
    } else {
        PG8_STAGE(PG8_SB(0, 0), cB, voffB); PG8_STAGE(PG8_SA(0, 0), cA, voffA); PG8_STAGE(PG8_SB(0, 1), cB + hstep, voffB); PG8_STAGE(PG8_SA(0, 1), cA + hstep, voffA);
        if (wr == 1) PG8_BAR;
        PG8_WAIT_V(4); PG8_BAR;
        PG8_STAGE(PG8_SB(1, 0), cB + kstep, voffB); PG8_STAGE(PG8_SA(1, 0), cA + kstep, voffA); PG8_STAGE(PG8_SB(1, 1), cB + hstep + kstep, voffB);
        PG8_WAIT_V(6); PG8_BAR;
    }
    for (;;) {
        const bool has_next = S.next(ui + 1, nxt);
        const char* nA = has_next ? (const char*)g.A + (size_t)nxt.pm * tstep : cA; const char* nB = has_next ? (const char*)g.Bt + (size_t)nxt.pn * tstep : cB;
        for (int t = 0; t < nt; t += 2) {
            const bool last = (t == nt - 2);
            const char* a1 = cA + (size_t)(t + 1) * kstep;
            const char* a2 = last ? nA : cA + (size_t)(t + 2) * kstep; const char* b2 = last ? nB : cB + (size_t)(t + 2) * kstep;
            const char* a3 = a2 + kstep; const char* b3 = b2 + kstep;
            if (last && has_next) S.a_ready(nxt);
            if constexpr (SP2) {
            PG8_LDB(B0, 0, 0); PG8_LDB(B1, 0, 1); PG8_SCHED; PG8_LDA(At, 0, 0); PG8_STAGE(PG8_SA(1, 1), a1 + hstep, voffA);
            PG8_WAIT_V(8); PG8_WAIT_L(0); PG8_BAR; PG8_MMA(0, 0, At, B0); PG8_MMA(0, 1, At, B1); PG8_BAR; PG8_SCHED;
            PG8_LDA(At, 0, 1); PG8_STAGE(PG8_SB(0, 0), b2, voffB); PG8_STAGE(PG8_SB(0, 1), b2 + hstep, voffB); PG8_STAGE(PG8_SA(0, 0), a2, voffA);
            PG8_WAIT_V(8); PG8_WAIT_L(0); PG8_BAR; PG8_MMA(1, 0, At, B0); PG8_MMA(1, 1, At, B1); PG8_BAR; PG8_SCHED;
            PG8_LDB(B0, 1, 0); PG8_LDB(B1, 1, 1); PG8_SCHED; PG8_LDA(At, 1, 0); PG8_STAGE(PG8_SA(0, 1), a2 + hstep, voffA);
            PG8_WAIT_V(8); PG8_WAIT_L(0); PG8_BAR; PG8_MMA(0, 0, At, B0); PG8_MMA(0, 1, At, B1); PG8_BAR; PG8_SCHED;
            PG8_LDA(At, 1, 1); PG8_STAGE(PG8_SB(1, 0), b3, voffB); PG8_STAGE(PG8_SB(1, 1), b3 + hstep, voffB); PG8_STAGE(PG8_SA(1, 0), a3, voffA);
            PG8_WAIT_V(8); PG8_WAIT_L(0); PG8_BAR; PG8_MMA(1, 0, At, B0); PG8_MMA(1, 1, At, B1); PG8_BAR; PG8_SCHED;
            } else {
            PG8_LDB(B0, 0, 0); PG8_SCHED; PG8_LDA(At, 0, 0); PG8_STAGE(PG8_SA(1, 1), a1 + hstep, voffA);
            PG8_WAIT_L(8); PG8_BAR; PG8_WAIT_L(0); PG8_MMA(0, 0, At, B0); PG8_BAR; PG8_SCHED;
            PG8_LDB(B1, 0, 1); PG8_STAGE(PG8_SB(0, 0), b2, voffB);
            PG8_BAR; PG8_WAIT_L(0); PG8_MMA(0, 1, At, B1); PG8_BAR;
            PG8_LDA(At, 0, 1); PG8_STAGE(PG8_SA(0, 0), a2, voffA);
            PG8_BAR; PG8_WAIT_L(0); PG8_MMA(1, 0, At, B0); PG8_BAR; PG8_SCHED;
            PG8_STAGE(PG8_SB(0, 1), b2 + hstep, voffB);
            PG8_WAIT_V(6); PG8_BAR; PG8_MMA(1, 1, At, B1); PG8_BAR;
            PG8_LDB(B0, 1, 0); PG8_SCHED; PG8_LDA(At, 1, 0); PG8_STAGE(PG8_SA(0, 1), a2 + hstep, voffA);
            PG8_WAIT_L(8); PG8_BAR; PG8_WAIT_L(0); PG8_MMA(0, 0, At, B0); PG8_BAR; PG8_SCHED;
            PG8_LDB(B1, 1, 1); PG8_STAGE(PG8_SB(1, 0), b3, voffB);
            PG8_BAR; PG8_WAIT_L(0); PG8_MMA(0, 1, At, B1); PG8_BAR;
            PG8_LDA(At, 1, 1); PG8_STAGE(PG8_SA(1, 0), a3, voffA);
            PG8_BAR; PG8_WAIT_L(0); PG8_MMA(1, 0, At, B0); PG8_BAR; PG8_SCHED;
            PG8_STAGE(PG8_SB(1, 1), b3 + hstep, voffB);
            PG8_WAIT_V(6); PG8_BAR; PG8_MMA(1, 1, At, B1); PG8_BAR;
            }
        }
        if constexpr (ALIGN_EPI) { if (wr == 0) PG8_BAR; }
        if constexpr (!Epi::AFTER_DRAIN) { E(acc, cur, wr, wc, fr, fq); S.done(cur); }
        if (!has_next) break;
#pragma unroll
        for (int a = 0; a < 2; ++a)
#pragma unroll
            for (int b = 0; b < 2; ++b)
#pragma unroll
                for (int m = 0; m < 4; ++m)
#pragma unroll
                    for (int n = 0; n < 2; ++n) acc[a][b][m][n] = (f32x4){0.f, 0.f, 0.f, 0.f};
        cur = nxt; cA = nA; cB = nB; ++ui;
        if constexpr (ALIGN_EPI) { if (wr == 1) PG8_BAR; }
    }
    PG8_WAIT_V(0);
    if constexpr (!ALIGN_EPI) { if (wr == 0) PG8_BAR; }
    PG8_BAR;
    if constexpr (Epi::AFTER_DRAIN) { E.fused(acc, cur, wr, wc, fr, fq, lds, wid, lane); S.done(cur); }
#undef PG8_SA
#undef PG8_SB
#undef PG8_STAGE
#undef PG8_LDA
#undef PG8_LDB
#undef PG8_MMA
#undef PG8_WAIT_V
#undef PG8_WAIT_L
#undef PG8_BAR
#undef PG8_SCHED
}
}
#define LAS __attribute__((address_space(3)))
typedef unsigned short bf16_t;
typedef short bf16x8 __attribute__((ext_vector_type(8)));
typedef short s16x4 __attribute__((ext_vector_type(4)));
typedef float f32x4 __attribute__((ext_vector_type(4)));
typedef float f32x2 __attribute__((ext_vector_type(2)));
typedef float f32x16 __attribute__((ext_vector_type(16)));
typedef unsigned u32x4 __attribute__((ext_vector_type(4)));
typedef unsigned u32x2 __attribute__((ext_vector_type(2)));
typedef short v4i16_t __attribute__((ext_vector_type(4)));

constexpr int L = 16384, DM = 1024, DFF = 2816, NW = 8;
constexpr int EV_IN = 3072, OD_IN = 2048;
constexpr float EPS = 1e-6f;
constexpr size_t MiB = 1u << 20;
constexpr size_t WS_WEVIN = 0, WS_WEVOUT = 6 * MiB, WS_WODIN = 8 * MiB, WS_WODOUT = 12 * MiB, WS_WGLU = 14 * MiB, WS_WFFIN = 15 * MiB, WS_WFFOUT = 37 * MiB;
constexpr size_t WFFIN_STRIDE = (size_t)5632 * 1024 * 2, WFFOUT_STRIDE = (size_t)1024 * 2816 * 2;
constexpr size_t WS_AP = 48 * MiB;
constexpr size_t WS_PROJ = 80 * MiB;
constexpr size_t WS_YG = WS_PROJ + 64 * MiB;
constexpr size_t WS_CAT = 176 * MiB;
constexpr size_t WS_MODP = 208 * MiB;
constexpr size_t WS_MOD = 210 * MiB;
constexpr size_t WS_GM = WS_MOD + 64 * 1024;
constexpr size_t WS_BV = WS_GM + 64 * 1024;
constexpr size_t WS_ROWSS = 242 * MiB;
constexpr size_t WS_ROPE = 212 * MiB;
constexpr size_t WS_HEADV = 216 * MiB, WS_HEADG = 218 * MiB, WS_TAILG = 220 * MiB;
constexpr size_t WS_RETL = 222 * MiB, WS_RETC = 230 * MiB;
constexpr size_t WS_S5L = 238 * MiB, WS_S5C = 239 * MiB;
constexpr size_t WS_S5P = 240 * MiB;
constexpr size_t WS_S5A = WS_S5P + 64 * 1024;
constexpr size_t WS_CTL = 248 * MiB, CTL_BYTES = 65536;
constexpr size_t WS_END = 249 * MiB;
constexpr int LDS_STAGE = 131072;
constexpr int LDS_XG = 131072;
constexpr int LDS_CTL = 131072 + 4096;
constexpr int LDS_BYTES = 147456;

struct Args { const float* in[28]; float* out; unsigned char* ws; };
typedef __attribute__((address_space(4))) const unsigned char* kptr_t;
__device__ __forceinline__ kptr_t kargs_fresh() { kptr_t p = (kptr_t)__builtin_amdgcn_kernarg_segment_ptr(); asm volatile("" : "+s"(p)); return p; }
__device__ __forceinline__ kptr_t klaunder(kptr_t p) { asm volatile("" : "+s"(p)); return p; }
__device__ __forceinline__ const float* karg_in(kptr_t kp, int i) { return (const float*)(*(__attribute__((address_space(1))) const float* const __attribute__((address_space(4)))*)(kp + 8 * i)); }
__device__ __forceinline__ float* karg_out(kptr_t kp) { return (float*)(*(__attribute__((address_space(1))) float* const __attribute__((address_space(4)))*)(kp + 224)); }
__device__ __forceinline__ unsigned char* karg_ws(kptr_t kp) { return (unsigned char*)(*(__attribute__((address_space(1))) unsigned char* const __attribute__((address_space(4)))*)(kp + 232)); }

enum { I_X = 0, I_C, I_T5, I_MODW, I_MODB, I_N1G, I_N2G, I_FFIN, I_CONVW, I_CONVB, I_FFOUT, I_EVIN, I_EVOUT, I_DLAM, I_SUBLN, I_RELB, I_ODIN, I_ODOUT, I_LRE, I_LIM, I_LSTEP, I_BRE, I_BIM, I_CRE, I_CIM, I_S5D, I_GLU, I_FING };

__device__ __forceinline__ unsigned cvtpk(float lo, float hi) { unsigned r; asm volatile("v_cvt_pk_bf16_f32 %0, %1, %2" : "=v"(r) : "v"(lo), "v"(hi)); return r; }
__device__ __forceinline__ float bf_lo(unsigned w) { return __uint_as_float(w << 16); }
__device__ __forceinline__ float bf_hi(unsigned w) { return __uint_as_float(w & 0xffff0000u); }
__device__ __forceinline__ float bf1(bf16_t v) { return __uint_as_float(((unsigned)v) << 16); }
__device__ __forceinline__ float wave_sum(float v) {
#pragma unroll
    for (int o = 1; o < 64; o <<= 1) v += __shfl_xor(v, o);
    return v;
}
__device__ __forceinline__ float half_sum(float v) {
#pragma unroll
    for (int o = 1; o < 32; o <<= 1) v += __shfl_xor(v, o);
    return v;
}
__device__ __forceinline__ float swap32f(float v) { return __shfl_xor(v, 32); }
__device__ __forceinline__ int crow(int r, int hi) { return (r & 3) + 8 * (r >> 2) + 4 * hi; }
#define LDSW() asm volatile("s_waitcnt lgkmcnt(0)" ::: "memory")
#define VMW() asm volatile("s_waitcnt vmcnt(0)" ::: "memory")
__device__ __forceinline__ void bar_sync() { asm volatile("s_waitcnt vmcnt(0) lgkmcnt(0)" ::: "memory"); __builtin_amdgcn_s_barrier(); asm volatile("" ::: "memory"); }
__device__ __forceinline__ float sigmoidf_(float x) { return __builtin_amdgcn_rcpf(1.0f + __builtin_amdgcn_exp2f(-1.4426950408889634f * x)); }
__device__ __forceinline__ float gelu_t(float x) { const float u = 0.7978845608028654f * (x + 0.044715f * x * x * x); return x * __builtin_amdgcn_rcpf(1.0f + __builtin_amdgcn_exp2f(-2.8853900817779268f * u)); }

__device__ __forceinline__ void sincos_d(double x, double& s, double& c) {
    const double n = __builtin_rint(x * 0.63661977236758134308);
    double r = __builtin_fma(-n, 1.57079632673412561417e+00, x);
    r = __builtin_fma(-n, 6.07710050630396597660e-11, r);
    r = __builtin_fma(-n, 2.02226624879595063154e-21, r);
    const double z = r * r;
    double ps = -1.0 / 1307674368000.0;
    ps = __builtin_fma(ps, z, 1.0 / 6227020800.0);
    ps = __builtin_fma(ps, z, -1.0 / 39916800.0);
    ps = __builtin_fma(ps, z, 1.0 / 362880.0);
    ps = __builtin_fma(ps, z, -1.0 / 5040.0);
    ps = __builtin_fma(ps, z, 1.0 / 120.0);
    ps = __builtin_fma(ps, z, -1.0 / 6.0);
    const double sr = __builtin_fma(ps * z, r, r);
    double pc = 1.0 / 20922789888000.0;
    pc = __builtin_fma(pc, z, -1.0 / 87178291200.0);
    pc = __builtin_fma(pc, z, 1.0 / 479001600.0);
    pc = __builtin_fma(pc, z, -1.0 / 3628800.0);
    pc = __builtin_fma(pc, z, 1.0 / 40320.0);
    pc = __builtin_fma(pc, z, -1.0 / 720.0);
    pc = __builtin_fma(pc, z, 1.0 / 24.0);
    pc = __builtin_fma(pc, z, -0.5);
    const double cr = __builtin_fma(pc, z, 1.0);
    const int q = ((int)(long long)n) & 3;
    s = (q == 0) ? sr : (q == 1) ? cr : (q == 2) ? -sr : -cr;
    c = (q == 0) ? cr : (q == 1) ? -sr : (q == 2) ? -cr : sr;
}

__device__ __forceinline__ int dst_row(int n, int N, int mode) {
    if (mode == 1) { if (n < 512) { const int j = n & 63; return (n & ~63) + ((j < 32) ? 2 * j : 2 * (j - 32) + 1); } return n; }
    if (mode == 2) { const int half = N >> 1, bj = n / half, rem = n - bj * half; return 256 * (rem >> 7) + 128 * bj + (rem & 127); }
    return n;
}
__device__ __forceinline__ void transpose_item(const float* W, int K, int N, bf16_t* WT, int mode, LAS float* scr, int item, int lane) {
    const int nblk = N / 32, kb = item / nblk, nb = item % nblk, k0 = 64 * kb, n0 = 32 * nb;
#pragma unroll 8
    for (int i = 0; i < 32; ++i) { const int kk = 2 * i + (lane >> 5); scr[kk * 33 + (lane & 31)] = W[(size_t)(k0 + kk) * N + n0 + (lane & 31)]; }
    LDSW();
    const int c = lane & 7;
#pragma unroll
    for (int j = 0; j < 4; ++j) { const int n = (lane >> 3) + 8 * j; const LAS float* s = scr + (8 * c) * 33 + n;
        u32x4 o; o.x = cvtpk(s[0 * 33], s[1 * 33]); o.y = cvtpk(s[2 * 33], s[3 * 33]); o.z = cvtpk(s[4 * 33], s[5 * 33]); o.w = cvtpk(s[6 * 33], s[7 * 33]);
        *(u32x4*)(WT + (size_t)dst_row(n0 + n, N, mode) * K + k0 + 8 * c) = o; }
    LDSW();
}
__device__ __forceinline__ void phase_p0a(kptr_t kp0, LAS unsigned char* lds, int vcu, int G) { const kptr_t kp = klaunder(kp0);
    const int tid = tid_opaque(), lane = tid & 63, wid = tid >> 6;
    unsigned char* ws = karg_ws(kp);
    LAS float* scr = (LAS float*)(lds + wid * 16384);
    const int gw = vcu * NW + wid, NGW = G * NW;
    constexpr int I0 = 16 * 96, I1 = 16 * 32, I2 = 16 * 64, I3 = 16 * 32, I4 = 8 * 32, I5 = 16 * 176, I6 = 44 * 32;
    constexpr int NIT = I0 + I1 + I2 + I3 + I4 + 2 * I5 + 2 * I6;
#pragma unroll 1
    for (int it = gw; it < NIT; it += NGW) {
        int r = it; const float* W; bf16_t* WT; int K, N, mode = 0;
        if (r < I0) { W = karg_in(kp, I_EVIN); WT = (bf16_t*)(ws + WS_WEVIN); K = 1024; N = 3072; }
        else if ((r -= I0) < I1) { W = karg_in(kp, I_EVOUT); WT = (bf16_t*)(ws + WS_WEVOUT); K = 1024; N = 1024; }
        else if ((r -= I1) < I2) { W = karg_in(kp, I_ODIN); WT = (bf16_t*)(ws + WS_WODIN); K = 1024; N = 2048; mode = 1; }
        else if ((r -= I2) < I3) { W = karg_in(kp, I_ODOUT); WT = (bf16_t*)(ws + WS_WODOUT); K = 1024; N = 1024; }
        else if ((r -= I3) < I4) { W = karg_in(kp, I_GLU); WT = (bf16_t*)(ws + WS_WGLU); K = 512; N = 1024; mode = 2; }
        else if ((r -= I4) < 2 * I5) { const int l = r / I5; r -= l * I5; W = karg_in(kp, I_FFIN) + (size_t)l * 1024 * 5632; WT = (bf16_t*)(ws + WS_WFFIN + l * WFFIN_STRIDE); K = 1024; N = 5632; mode = 2; }
        else { r -= 2 * I5; const int l = r / I6; r -= l * I6; W = karg_in(kp, I_FFOUT) + (size_t)l * 2816 * 1024; WT = (bf16_t*)(ws + WS_WFFOUT + l * WFFOUT_STRIDE); K = 2816; N = 1024; }
        transpose_item(W, K, N, WT, mode, scr, r, lane);
    }
    for (int b = vcu; b < 256; b += G) {
        const int kb = b >> 3, cg = b & 7;
        float accv[3] = {0.f, 0.f, 0.f};
        for (int kk = 0; kk < 32; ++kk) { const int k = kb * 32 + kk; const float cv = karg_in(kp, I_C)[k]; const float cond = cv * sigmoidf_(cv);
#pragma unroll
            for (int j = 0; j < 3; ++j) { const int cidx = cg * 1536 + tid + 512 * j, ly = cidx / 6144, n = cidx - ly * 6144; accv[j] += cond * karg_in(kp, I_MODW)[((size_t)ly * 1024 + k) * 6144 + n]; } }
#pragma unroll
        for (int j = 0; j < 3; ++j) ((float*)(ws + WS_MODP))[(size_t)kb * 12288 + cg * 1536 + tid + 512 * j] = accv[j];
    }
    const int gid = vcu * 512 + tid, GN = G * 512;
    for (int e = gid; e < 2048; e += GN) { const int g = e >> 6;
        const double step = exp((double)karg_in(kp, I_LSTEP)[g]); const double lre = karg_in(kp, I_LRE)[e], lim = karg_in(kp, I_LIM)[e];
        const double mag = exp(lre * step); double sn, cs; sincos_d(lim * step, sn, cs);
        const double dar = mag * cs, dai = mag * sn, nr = dar - 1.0, ni = dai, den = lre * lre + lim * lim;
        ((f32x4*)(ws + WS_S5P))[e] = (f32x4){(float)dar, (float)dai, (float)((nr * lre + ni * lim) / den), (float)((ni * lre - nr * lim) / den)};
        const double mag2 = exp(lre * step * 256.0); sincos_d(lim * step * 256.0, sn, cs);
        ((f32x2*)(ws + WS_S5A))[e] = (f32x2){(float)(mag2 * cs), (float)(mag2 * sn)}; }
    for (int e = gid; e < L * 32; e += GN) { const int pos = e >> 5, i = e & 31;
        const float pf = (float)exp2(13.287712379549449 * (double)i / 32.0);
        const float inv = 1.0f / pf; const float ang = (float)pos * inv;
        double s, c; sincos_d((double)ang, s, c);
        ((f32x2*)(ws + WS_ROPE))[e] = (f32x2){(float)c, (float)s}; }
}
__device__ __forceinline__ void phase_p0b(kptr_t kp0, int vcu, int G) { const kptr_t kp = klaunder(kp0);
    const int gid = vcu * 512 + tid_opaque(), GN = G * 512;
    const float* mp = (const float*)(karg_ws(kp) + WS_MODP);
    for (int c = gid; c < 12288; c += GN) { float s = karg_in(kp, I_MODB)[c];
        for (int kb = 0; kb < 32; ++kb) s += mp[(size_t)kb * 12288 + c];
        ((float*)(karg_ws(kp) + WS_MOD))[c] = s; }
}
__device__ __forceinline__ void phase_p0c(kptr_t kp0, int vcu, int G) { const kptr_t kp = klaunder(kp0);
    const int tid = tid_opaque(), lane = tid & 63, wid = tid >> 6;
    const int gid = vcu * 512 + tid, GN = G * 512, gw = vcu * NW + wid, NGW = G * NW;
    const float* mod = (const float*)(karg_ws(kp) + WS_MOD);
    float* gm = (float*)(karg_ws(kp) + WS_GM);
    for (int i = gid; i < 4096; i += GN) { const int v = i >> 10, k = i & 1023, ly = v >> 1, second = v & 1;
        const float g = (second ? karg_in(kp, I_N2G) : karg_in(kp, I_N1G))[ly * 1024 + k]; const float sc = mod[ly * 6144 + (second ? 4096 : 1024) + k];
        gm[i] = g * (1.0f + sc); }
    f32x4 gv[4];
#pragma unroll
    for (int j = 0; j < 4; ++j) { const int k = 4 * lane + 256 * j; const f32x4 g = *(const f32x4*)(karg_in(kp, I_N1G) + k), sc = *(const f32x4*)(mod + 1024 + k); gv[j] = g * (sc + 1.0f); }
    bf16_t* AP = (bf16_t*)(karg_ws(kp) + WS_AP); float* rowss = (float*)(karg_ws(kp) + WS_ROWSS);
    for (int m = gw; m < L; m += NGW) {
        const f32x4* xr = (const f32x4*)(karg_in(kp, I_X) + (size_t)m * 1024) + lane; float s = 0.f; f32x4 v[4];
#pragma unroll
        for (int j = 0; j < 4; ++j) { v[j] = xr[64 * j]; s += (v[j][0] * v[j][0] + v[j][1] * v[j][1]) + (v[j][2] * v[j][2] + v[j][3] * v[j][3]); }
        s = wave_sum(s);
        u32x2* o8 = (u32x2*)(AP + (size_t)m * 1024) + lane;
#pragma unroll
        for (int j = 0; j < 4; ++j) { const f32x4 t = v[j] * gv[j]; o8[64 * j] = (u32x2){cvtpk(t[0], t[1]), cvtpk(t[2], t[3])}; }
        if (lane < 16) rowss[(size_t)m * 16 + lane] = (lane == 0) ? s : 0.f;
    }
    float* bvec = (float*)(karg_ws(kp) + WS_BV);
    for (int r = gw; r < 16384; r += NGW) {
        const bf16_t* wrow; const float* sh;
        if (r < 3072) { wrow = (const bf16_t*)(karg_ws(kp) + WS_WEVIN) + (size_t)r * 1024; sh = mod; }
        else if (r < 5120) { wrow = (const bf16_t*)(karg_ws(kp) + WS_WODIN) + (size_t)(r - 3072) * 1024; sh = mod + 6144; }
        else if (r < 10752) { wrow = (const bf16_t*)(karg_ws(kp) + WS_WFFIN) + (size_t)(r - 5120) * 1024; sh = mod + 3072; }
        else { wrow = (const bf16_t*)(karg_ws(kp) + WS_WFFIN + WFFIN_STRIDE) + (size_t)(r - 10752) * 1024; sh = mod + 6144 + 3072; }
        float s = 0.f;
#pragma unroll
        for (int j = 0; j < 2; ++j) { const int k = 8 * lane + 512 * j; const u32x4 w = *(const u32x4*)(wrow + k); const f32x4 s0 = *(const f32x4*)(sh + k), s1 = *(const f32x4*)(sh + k + 4);
            s += bf_lo(w.x) * s0[0] + bf_hi(w.x) * s0[1] + bf_lo(w.y) * s0[2] + bf_hi(w.y) * s0[3] + bf_lo(w.z) * s1[0] + bf_hi(w.z) * s1[1] + bf_lo(w.w) * s1[2] + bf_hi(w.w) * s1[3]; }
        s = wave_sum(s);
        if (lane == 0) bvec[r] = s;
    }
}
#define PV_ASM 1
constexpr int AT_STG = 32768;
constexpr int AT_BIAS = 65536, AT_WSF = 65536 + 1024, AT_POST = 0;
constexpr float AT_THR = 8.0f;
__device__ __forceinline__ bf16x8 tr_frag(const LAS unsigned char* p) {
    const s16x4 lo = __builtin_bit_cast(s16x4, __builtin_amdgcn_ds_read_tr16_b64_v4i16((LAS v4i16_t*)p));
    const s16x4 hi = __builtin_bit_cast(s16x4, __builtin_amdgcn_ds_read_tr16_b64_v4i16((LAS v4i16_t*)(p + 512)));
    return (bf16x8){lo[0], lo[1], lo[2], lo[3], hi[0], hi[1], hi[2], hi[3]};
}
__device__ __forceinline__ bf16x8 pack8(const f32x16& p, int b) {
    u32x4 w; w.x = cvtpk(p[b], p[b + 1]); w.y = cvtpk(p[b + 2], p[b + 3]); w.z = cvtpk(p[b + 4], p[b + 5]); w.w = cvtpk(p[b + 6], p[b + 7]);
    return __builtin_bit_cast(bf16x8, w);
}
#define MFMA32(a, b, c) __builtin_amdgcn_mfma_f32_32x32x16_bf16(a, b, c, 0, 0, 0)

template <int DV, bool DIFF>
__device__ __forceinline__ void attn_unit(LAS unsigned char* lds, const bf16_t* proj, bf16_t* cat, int h, int q0, int T0, int T1,
                                          int qcol, int kcol, int vcol, int ocol, float lam, const float* subg, float lam_init) {
    constexpr int ND = DV / 32, NV = DV / 64, VOFF = DIFF ? 16384 : 8192;
    const int tid = tid_opaque(), lane = tid & 63, r32 = lane & 31, hi = lane >> 5; const int wid = __builtin_amdgcn_readfirstlane(tid >> 6);
    const int wq = DIFF ? (wid & 3) : wid, sub = DIFF ? (wid >> 2) : 0;
    const int rowbase = q0 + 32 * wq, cw = rowbase >> 6;
    const int tlo = DIFF ? 0 : (cw - 8), thi = cw;
    LAS float* btab = (LAS float*)(lds + AT_BIAS);
    LAS float* wsf = (LAS float*)(lds + AT_WSF) + wid * 64;
    bf16x8 qr[4];
    { const bf16_t* Qw = proj + (size_t)(rowbase + r32) * EV_IN + qcol + sub * 64 + hi * 8;
#pragma unroll
      for (int d0 = 0; d0 < 4; ++d0) qr[d0] = *(const bf16x8*)(Qw + d0 * 16); }
    const bf16_t* ksrc = proj + (size_t)lane * EV_IN + kcol + wid * 8;
    const bf16_t* vsrc = proj + (size_t)(16 * (wid & 3) + (lane >> 2)) * EV_IN + vcol + (wid >> 2) * 32 + (lane & 3) * 8;
    const int kdst = wid * 1024 + lane * 16, vdst = VOFF + (wid >> 2) * 4096 + (wid & 3) * 1024 + lane * 16;
    u32x4 sk0, sk1 = (u32x4){0u, 0u, 0u, 0u}, sv[NV];
#define AT_GLOAD(t_) do { const size_t ro_ = (size_t)(t_) * 64 * EV_IN; sk0 = *(const u32x4*)(ksrc + ro_); if (DIFF) sk1 = *(const u32x4*)(ksrc + ro_ + 64); \
        _Pragma("unroll") for (int j_ = 0; j_ < NV; ++j_) sv[j_] = *(const u32x4*)(vsrc + ro_ + j_ * 64); } while (0)
#define AT_LSTORE(s_) do { LAS unsigned char* st_ = lds + (s_) * AT_STG; *(LAS u32x4*)(st_ + kdst) = sk0; if (DIFF) *(LAS u32x4*)(st_ + 8192 + kdst) = sk1; \
        _Pragma("unroll") for (int j_ = 0; j_ < NV; ++j_) *(LAS u32x4*)(st_ + vdst + j_ * 8192) = sv[j_]; } while (0)
    float mref = -1e30f, lsum = 0.f;
    f32x16 o[ND];
#pragma unroll
    for (int d = 0; d < ND; ++d) o[d] = (f32x16){};
    const int kfo = (DIFF ? sub * 8192 : 0) + hi * 1024 + r32 * 16;
    const int vfo = VOFF + ((lane >> 4) & 1) * 32 + (lane & 3) * 8 + (4 * hi + ((lane & 15) >> 2)) * 64;
    AT_GLOAD(T0); AT_LSTORE(0); bar_sync();
    for (int t = T0; t <= T1; ++t) {
        const int s = (t - T0) & 1;
        if (t < T1) AT_GLOAD(t + 1);
        if (t >= tlo && t <= thi) {
            const LAS unsigned char* st = lds + s * AT_STG;
            f32x16 p0 = (f32x16){}, p1 = (f32x16){};
#pragma unroll
            for (int d0 = 0; d0 < 4; ++d0) {
                const bf16x8 b0 = *(const LAS bf16x8*)(st + kfo + d0 * 2048), b1 = *(const LAS bf16x8*)(st + kfo + d0 * 2048 + 512);
                p0 = MFMA32(b0, qr[d0], p0); p1 = MFMA32(b1, qr[d0], p1); }
            if (t >= cw - 2) {
                const int ib = 64 * t - (rowbase + r32) + 191 + 4 * hi;
#pragma unroll
                for (int r = 0; r < 16; ++r) { const int kv = (r & 3) + 8 * (r >> 2); p0[r] += btab[ib + kv]; p1[r] += btab[ib + kv + 32]; }
            }
            float rm = p0[0];
#pragma unroll
            for (int r = 1; r < 16; ++r) rm = fmaxf(rm, p0[r]);
#pragma unroll
            for (int r = 0; r < 16; ++r) rm = fmaxf(rm, p1[r]);
            rm = fmaxf(rm, swap32f(rm));
            if (__any(rm > mref + AT_THR)) {
                const float mnew = fmaxf(mref, rm), f = __builtin_amdgcn_exp2f(mref - mnew);
                mref = mnew; lsum *= f;
                if (hi == 0) wsf[r32] = f;
                LDSW();
#pragma unroll
                for (int r = 0; r < 16; ++r) { const float fr_ = wsf[crow(r, hi)];
#pragma unroll
                    for (int d = 0; d < ND; ++d) o[d][r] *= fr_; }
            }
            float sacc = 0.f;
#pragma unroll
            for (int r = 0; r < 16; ++r) { p0[r] = __builtin_amdgcn_exp2f(p0[r] - mref); p1[r] = __builtin_amdgcn_exp2f(p1[r] - mref); sacc += p0[r] + p1[r]; }
            lsum += sacc;
            const bf16x8 pw0 = pack8(p0, 0), pw1 = pack8(p0, 8), pw2 = pack8(p1, 0), pw3 = pack8(p1, 8);
#ifdef PV_ASM
            { const unsigned vaddr = (unsigned)(size_t)(st + vfo); s16x4 va[8], vb[8];
#define AT_VRD(buf_, d_) do { _Pragma("unroll") for (int ks_ = 0; ks_ < 4; ++ks_) { \
        asm volatile("ds_read_b64_tr_b16 %0, %1 offset:%c2" : "=&v"(buf_[2 * ks_]) : "v"(vaddr), "i"((d_) * 4096 + ks_ * 1024) : "memory"); \
        asm volatile("ds_read_b64_tr_b16 %0, %1 offset:%c2" : "=&v"(buf_[2 * ks_ + 1]) : "v"(vaddr), "i"((d_) * 4096 + ks_ * 1024 + 512) : "memory"); } } while (0)
#define AT_VF(buf_, ks_) ((bf16x8){buf_[2 * (ks_)][0], buf_[2 * (ks_)][1], buf_[2 * (ks_)][2], buf_[2 * (ks_)][3], buf_[2 * (ks_) + 1][0], buf_[2 * (ks_) + 1][1], buf_[2 * (ks_) + 1][2], buf_[2 * (ks_) + 1][3]})
#define AT_PVD(buf_, d_) do { o[d_] = MFMA32(pw0, AT_VF(buf_, 0), o[d_]); o[d_] = MFMA32(pw1, AT_VF(buf_, 1), o[d_]); o[d_] = MFMA32(pw2, AT_VF(buf_, 2), o[d_]); o[d_] = MFMA32(pw3, AT_VF(buf_, 3), o[d_]); } while (0)
#define AT_WAITV(n_, b_) asm volatile("s_waitcnt lgkmcnt(" #n_ ")" : "+v"(b_[0]), "+v"(b_[1]), "+v"(b_[2]), "+v"(b_[3]), "+v"(b_[4]), "+v"(b_[5]), "+v"(b_[6]), "+v"(b_[7]) :: "memory")
              AT_VRD(va, 0); AT_VRD(vb, 1);
              AT_WAITV(8, va); AT_PVD(va, 0);
              if (ND > 2) { AT_VRD(va, 2); AT_WAITV(8, vb); AT_PVD(vb, 1); AT_VRD(vb, 3); AT_WAITV(8, va); AT_PVD(va, 2); AT_WAITV(0, vb); AT_PVD(vb, 3); }
              else { AT_WAITV(0, vb); AT_PVD(vb, 1); }
#undef AT_VRD
#undef AT_VF
#undef AT_PVD
#undef AT_WAITV
            }
#else
#pragma unroll
            for (int d = 0; d < ND; ++d) {
                const LAS unsigned char* vp = st + vfo + d * 4096;
                o[d] = MFMA32(pw0, tr_frag(vp), o[d]); o[d] = MFMA32(pw1, tr_frag(vp + 1024), o[d]);
                o[d] = MFMA32(pw2, tr_frag(vp + 2048), o[d]); o[d] = MFMA32(pw3, tr_frag(vp + 3072), o[d]); }
#endif
        }
        if (t < T1) AT_LSTORE(s ^ 1);
        bar_sync();
    }
    lsum += swap32f(lsum);
    if (hi == 0) wsf[32 + r32] = 1.0f / lsum;
    LDSW();
#pragma unroll
    for (int r = 0; r < 16; ++r) { const float inv = wsf[32 + crow(r, hi)];
#pragma unroll
        for (int d = 0; d < ND; ++d) o[d][r] *= inv; }
    if (DIFF) {
        LAS float* xo = (LAS float*)(lds + AT_POST) + wq * 4096;
        if (sub == 1) {
#pragma unroll
            for (int r = 0; r < 16; ++r)
#pragma unroll
                for (int d = 0; d < ND; ++d) xo[crow(r, hi) * 128 + 32 * d + r32] = o[d][r];
        }
        bar_sync();
        LAS bf16_t* stg = (LAS bf16_t*)(lds + 65536 + 4096) + wq * 4096;
        if (sub == 0) {
            float gl[ND];
#pragma unroll
            for (int d = 0; d < ND; ++d) gl[d] = subg[32 * d + r32] * (1.0f - lam_init);
#pragma unroll
            for (int r = 0; r < 16; ++r) { float ss = 0.f;
#pragma unroll
                for (int d = 0; d < ND; ++d) { o[d][r] -= lam * xo[crow(r, hi) * 128 + 32 * d + r32]; ss += o[d][r] * o[d][r]; }
                ss = half_sum(ss);
                const float rs = 1.0f / sqrtf(ss * (1.0f / 128.0f) + EPS);
#pragma unroll
                for (int d = 0; d < ND; ++d) stg[crow(r, hi) * 128 + 32 * d + r32] = (bf16_t)(cvtpk(o[d][r] * rs * gl[d], 0.f) & 0xffffu); }
            LDSW();
#pragma unroll
            for (int i = 0; i < 8; ++i) { const int row = i * 4 + (lane >> 4), ch = lane & 15; const u32x4 v = *(const LAS u32x4*)(stg + row * 128 + ch * 8);
                *(u32x4*)(cat + (size_t)(rowbase + row) * 1024 + ocol + ch * 8) = v; }
        }
        bar_sync();
    } else {
        LAS bf16_t* stg = (LAS bf16_t*)(lds + AT_POST) + wid * 2048;
#pragma unroll
        for (int r = 0; r < 16; ++r)
#pragma unroll
            for (int d = 0; d < ND; ++d) stg[crow(r, hi) * 64 + 32 * d + r32] = (bf16_t)(cvtpk(o[d][r], 0.f) & 0xffffu);
        LDSW();
#pragma unroll
        for (int i = 0; i < 4; ++i) { const int row = i * 8 + (lane >> 3), ch = lane & 7; const u32x4 v = *(const LAS u32x4*)(stg + row * 64 + ch * 8);
            *(u32x4*)(cat + (size_t)(rowbase + row) * 1024 + ocol + ch * 8) = v; }
        bar_sync();
    }
}
__device__ __forceinline__ int t5_bucket(int rel) {
    const int n = rel < 0 ? -rel : rel; int b = rel > 0 ? 16 : 0;
    if (n < 8) return b + n;
    int lg = 31 - __builtin_clz((unsigned)((n * n) >> 6)); lg = 8 + lg; if (lg > 15) lg = 15;
    return b + lg;
}
__device__ __forceinline__ void phase_attn(kptr_t kp0, LAS unsigned char* lds, int vcu, int G) { const kptr_t kp = klaunder(kp0);
    const int tid = tid_opaque();
    const bf16_t* proj = (const bf16_t*)(karg_ws(kp) + WS_PROJ); bf16_t* cat = (bf16_t*)(karg_ws(kp) + WS_CAT);
    LAS float* btab = (LAS float*)(lds + AT_BIAS);
    const float lam_init = 0.2f;
    float d1 = 0.f, d2 = 0.f;
    for (int i = 0; i < 64; ++i) { d1 += karg_in(kp, I_DLAM)[i] * karg_in(kp, I_DLAM)[64 + i]; d2 += karg_in(kp, I_DLAM)[128 + i] * karg_in(kp, I_DLAM)[192 + i]; }
    const float lam = expf(d1) - expf(d2) + lam_init;
    for (int pu = vcu; pu < 256; pu += G) {
        const int h = pu >> 6, pr = pu & 63;
        if (tid < 255) { const int rel = tid - 191; btab[tid] = (karg_in(kp, I_T5)[t5_bucket(rel) * 4 + h] - karg_in(kp, I_T5)[15 * 4 + h]) * 1.4426950408889634f; }
        bar_sync();
        for (int k = 0; k < 2; ++k) { const int qb = k ? (127 - pr) : pr;
            attn_unit<128, true>(lds, proj, cat, h, 128 * qb, 0, 2 * qb + 1, h * 128, 512 + h * 128, 1024 + h * 128, h * 128, lam, karg_in(kp, I_SUBLN), lam_init); }
    }
    for (int bu = vcu; bu < 512; bu += G) {
        const int h = bu >> 6, blk = bu & 63;
        bar_sync();
        if (tid < 255) { int rel = tid - 191; if (rel < -128) rel = -128; btab[tid] = (karg_in(kp, I_RELB)[h * 257 + rel + 128] - karg_in(kp, I_RELB)[h * 257]) * 1.4426950408889634f; }
        bar_sync();
        const int T0 = (4 * blk - 8) < 0 ? 0 : (4 * blk - 8);
        attn_unit<64, false>(lds, proj, cat, h, 256 * blk, T0, 4 * blk + 3, 1536 + h * 64, 2048 + h * 64, 2560 + h * 64, 512 + h * 64, 0.f, nullptr, 0.f);
    }
}
#define MFMA16(a, b, c) __builtin_amdgcn_mfma_f32_16x16x32_bf16(a, b, c, 0, 0, 0)
__device__ __forceinline__ float ret_lg2(int h) { return h == 0 ? -0.04580368961312479f : h == 1 ? -0.02272007650008353f : h == 2 ? -0.011315313227834146f : -0.005646563141142063f; }
__device__ __forceinline__ u32x4 scale8(u32x4 w, float s) {
    u32x4 o; o.x = cvtpk(bf_lo(w.x) * s, bf_hi(w.x) * s); o.y = cvtpk(bf_lo(w.y) * s, bf_hi(w.y) * s); o.z = cvtpk(bf_lo(w.z) * s, bf_hi(w.z) * s); o.w = cvtpk(bf_lo(w.w) * s, bf_hi(w.w) * s); return o;
}
__device__ __forceinline__ void phase_ret1(kptr_t kp0, LAS unsigned char* lds, int vcu, int G) { const kptr_t kp = klaunder(kp0);
    const int tid = tid_opaque(), lane = tid & 63, r32 = lane & 31, hi = lane >> 5; const int wid = __builtin_amdgcn_readfirstlane(tid >> 6);
    const bf16_t* proj = (const bf16_t*)(karg_ws(kp) + WS_PROJ); float* retl = (float*)(karg_ws(kp) + WS_RETL);
    const int lanepat = ((lane >> 4) & 1) * 32 + (lane & 3) * 8 + (4 * hi + ((lane & 15) >> 2)) * 64;
    for (int item = vcu; item < 256; item += G) {
        const int h = item & 3, grp = item >> 2, R0 = 256 * grp; const float lg2 = ret_lg2(h);
#pragma unroll
        for (int i = 0; i < 4; ++i) { const int p = tid + 512 * i, j = p >> 3, c = p & 7;
            const u32x4 w = *(const u32x4*)(proj + (size_t)(R0 + j) * OD_IN + 256 + h * 64 + 8 * c);
            *(LAS u32x4*)(lds + (c >> 2) * 16384 + (j >> 4) * 1024 + (j & 15) * 64 + (c & 3) * 16) = scale8(w, __builtin_amdgcn_exp2f(lg2 * (float)(255 - j))); }
#pragma unroll
        for (int i = 0; i < 8; ++i) { const int p = tid + 512 * i, j = p >> 4, c = p & 15;
            const u32x4 w = *(const u32x4*)(proj + (size_t)(R0 + j) * OD_IN + 512 + h * 128 + 8 * c);
            *(LAS u32x4*)(lds + 32768 + (c >> 2) * 16384 + (j >> 4) * 1024 + (j & 15) * 64 + (c & 3) * 16) = w; }
        bar_sync();
        const int db = wid >> 2, eb = wid & 3;
        f32x16 acc = (f32x16){};
#pragma unroll 4
        for (int ks = 0; ks < 16; ++ks) acc = MFMA32(tr_frag(lds + db * 16384 + ks * 1024 + lanepat), tr_frag(lds + 32768 + eb * 16384 + ks * 1024 + lanepat), acc);
        float* dst = retl + ((size_t)(grp * 4 + h) * 64 + 32 * db) * 128 + 32 * eb + r32;
#pragma unroll
        for (int r = 0; r < 16; ++r) dst[crow(r, hi) * 128] = acc[r];
        bar_sync();
    }
}
constexpr int RT_ST = 65536, RT_STB = 18432, RT_RS = 65536 + 2 * 18432;
__device__ __forceinline__ void phase_ret2(kptr_t kp0, LAS unsigned char* lds, int vcu, int G) { const kptr_t kp = klaunder(kp0);
    const int tid = tid_opaque(), lane = tid & 63, r32 = lane & 31, hi = lane >> 5; const int wid = __builtin_amdgcn_readfirstlane(tid >> 6);
    const bf16_t* proj = (const bf16_t*)(karg_ws(kp) + WS_PROJ); const float* retc = (const float*)(karg_ws(kp) + WS_RETC); bf16_t* cat = (bf16_t*)(karg_ws(kp) + WS_CAT);
    const int lanepat = ((lane >> 4) & 1) * 32 + (lane & 3) * 8 + (4 * hi + ((lane & 15) >> 2)) * 64;
    const int ib = wid >> 2, db = wid >> 2, eb = wid & 3;
    for (int item = vcu; item < 256; item += G) {
        const int h = item & 3, grp = item >> 2, R0 = 256 * grp; const float lg2 = ret_lg2(h); const float cd = __builtin_amdgcn_exp2f(lg2 * 64.0f);
        const bf16_t* kcs = proj + (size_t)(R0 + lane) * OD_IN + 256 + h * 64 + wid * 8;
        const int kcd = wid * 1024 + lane * 16;
        const int srow = 16 * (wid & 3) + (lane >> 2);
        const bf16_t* kds = proj + (size_t)(R0 + srow) * OD_IN + 256 + h * 64 + (wid >> 2) * 32 + (lane & 3) * 8;
        const int kdd = 8192 + (wid >> 2) * 4096 + (wid & 3) * 1024 + lane * 16;
        const bf16_t* vvs = proj + (size_t)(R0 + srow) * OD_IN + 512 + h * 128 + (wid >> 2) * 32 + (lane & 3) * 8;
        const int vvd = 16384 + (wid >> 2) * 4096 + (wid & 3) * 1024 + lane * 16;
        const float kdsc = __builtin_amdgcn_exp2f(lg2 * (float)(63 - srow));
        u32x4 s_kc, s_kd, s_v0, s_v1;
#define RT_GLOAD(c_) do { const size_t ro_ = (size_t)(c_) * 64 * OD_IN; s_kc = *(const u32x4*)(kcs + ro_); s_kd = *(const u32x4*)(kds + ro_); s_v0 = *(const u32x4*)(vvs + ro_); s_v1 = *(const u32x4*)(vvs + ro_ + 64); } while (0)
#define RT_LSTORE(s_) do { LAS unsigned char* st_ = lds + (s_) * 32768; *(LAS u32x4*)(st_ + kcd) = s_kc; *(LAS u32x4*)(st_ + kdd) = scale8(s_kd, kdsc); *(LAS u32x4*)(st_ + vvd) = s_v0; *(LAS u32x4*)(st_ + vvd + 8192) = s_v1; } while (0)
        f32x16 S;
        { const float* src = retc + ((size_t)(grp * 4 + h) * 64 + 32 * db) * 128 + 32 * eb + r32;
#pragma unroll
          for (int r = 0; r < 16; ++r) S[r] = src[crow(r, hi) * 128]; }
#define RT_STWRITE(sb_) do { LAS unsigned char* sp_ = lds + RT_ST + (sb_) * RT_STB + (32 * eb + r32) * 144 + (32 * db + 4 * hi) * 2; \
        _Pragma("unroll") for (int r4_ = 0; r4_ < 4; ++r4_) *(LAS u32x2*)(sp_ + r4_ * 16) = (u32x2){cvtpk(S[4 * r4_], S[4 * r4_ + 1]), cvtpk(S[4 * r4_ + 2], S[4 * r4_ + 3])}; } while (0)
        RT_STWRITE(0);
        RT_GLOAD(0); RT_LSTORE(0);
        bar_sync();
#pragma unroll 1
        for (int c = 0; c < 4; ++c) {
            const int s = c & 1, Rc = R0 + 64 * c;
            if (c < 3) RT_GLOAD(c + 1);
            const LAS unsigned char* st = lds + s * 32768;
            bf16x8 qr[4];
            { const bf16_t* Qw = proj + (size_t)(Rc + 32 * ib + r32) * OD_IN + h * 64 + hi * 8;
#pragma unroll
              for (int d0 = 0; d0 < 4; ++d0) qr[d0] = *(const bf16x8*)(Qw + d0 * 16); }
            f32x16 p0 = (f32x16){}, p1 = (f32x16){};
            const int kfo = hi * 1024 + r32 * 16;
#pragma unroll
            for (int d0 = 0; d0 < 4; ++d0) {
                const bf16x8 b0 = *(const LAS bf16x8*)(st + kfo + d0 * 2048), b1 = *(const LAS bf16x8*)(st + kfo + d0 * 2048 + 512);
                p0 = MFMA32(b0, qr[d0], p0); p1 = MFMA32(b1, qr[d0], p1); }
            int iloc = 32 * ib + r32; asm volatile("" : "+v"(iloc));
            int hio = hi; asm volatile("" : "+v"(hio));
#pragma unroll
            for (int r = 0; r < 16; ++r) { const int j = crow(r, hio); int d0_ = iloc - j; d0_ = d0_ < 0 ? -d0_ : d0_; int d1_ = iloc - j - 32; d1_ = d1_ < 0 ? -d1_ : d1_;
                p0[r] *= __builtin_amdgcn_exp2f(lg2 * (float)d0_); p1[r] *= __builtin_amdgcn_exp2f(lg2 * (float)d1_); }
            const bf16x8 pw0 = pack8(p0, 0), pw1 = pack8(p0, 8), pw2 = pack8(p1, 0), pw3 = pack8(p1, 8);
            const LAS unsigned char* vp = st + 16384 + eb * 4096 + lanepat;
            f32x16 o = (f32x16){};
            o = MFMA32(pw0, tr_frag(vp), o); o = MFMA32(pw1, tr_frag(vp + 1024), o); o = MFMA32(pw2, tr_frag(vp + 2048), o); o = MFMA32(pw3, tr_frag(vp + 3072), o);
            f32x16 cx = (f32x16){};
            { const LAS unsigned char* sp = lds + RT_ST + s * RT_STB + (32 * eb + r32) * 144 + hi * 16;
#pragma unroll
              for (int d0 = 0; d0 < 4; ++d0) cx = MFMA32(qr[d0], *(const LAS bf16x8*)(sp + d0 * 32), cx); }
            LAS float* rsb = (LAS float*)(lds + RT_RS);
#pragma unroll
            for (int r = 0; r < 16; ++r) { const int i = 32 * ib + crow(r, hio); o[r] += __builtin_amdgcn_exp2f(lg2 * (float)(i + 1)) * cx[r];
                const float ss = half_sum(o[r] * o[r]); if (r32 == 0) rsb[i * 4 + eb] = ss; }
            { const LAS unsigned char* kp = st + 8192 + db * 4096 + lanepat; f32x16 kv = (f32x16){};
#pragma unroll
              for (int ks = 0; ks < 4; ++ks) kv = MFMA32(tr_frag(kp + ks * 1024), tr_frag(vp + ks * 1024), kv);
#pragma unroll
              for (int r = 0; r < 16; ++r) S[r] = cd * S[r] + kv[r]; }
            bar_sync();
#pragma unroll
            for (int r = 0; r < 16; ++r) { const int i = 32 * ib + crow(r, hi); const f32x4 q4 = *(const LAS f32x4*)(rsb + i * 4);
                const float rs = 1.0f / sqrtf(((q4[0] + q4[1]) + (q4[2] + q4[3])) * (1.0f / 128.0f) + EPS);
                const float g = bf1(proj[(size_t)(Rc + i) * OD_IN + 1024 + h * 128 + 32 * eb + r32]);
                cat[(size_t)(Rc + i) * 1024 + h * 128 + 32 * eb + r32] = (bf16_t)(cvtpk(o[r] * rs * g * sigmoidf_(g), 0.f) & 0xffffu); }
            RT_STWRITE(s ^ 1);
            if (c < 3) RT_LSTORE(s ^ 1);
            bar_sync();
        }
    }
#undef RT_GLOAD
#undef RT_LSTORE
#undef RT_STWRITE
}
template <bool PASS2>
__device__ __forceinline__ void phase_s5(kptr_t kp0, LAS unsigned char* lds, int vcu, int G) { const kptr_t kp = klaunder(kp0);
    const int tid = tid_opaque(), lane = tid & 63; const int wid = __builtin_amdgcn_readfirstlane(tid >> 6);
    const int gw = vcu * NW + wid, NGW = G * NW;
    const bf16_t* proj = (const bf16_t*)(karg_ws(kp) + WS_PROJ); bf16_t* yg = (bf16_t*)(karg_ws(kp) + WS_YG);
    LAS float* ubuf = (LAS float*)(lds + wid * 6144);
    LAS bf16_t* xt = (LAS bf16_t*)(lds + wid * 6144 + 1024);
    for (int wi = gw; wi < 2048; wi += NGW) {
        const int g = wi & 31, seg = wi >> 5, t0 = seg * 256, n = lane;
        float ar, ai; f32x2 bb2[16];
        { const f32x4 prm = ((const f32x4*)(karg_ws(kp) + WS_S5P))[g * 64 + n]; ar = prm[0]; ai = prm[1]; const float cr = prm[2], ci = prm[3];
          const f32x4* br = (const f32x4*)(karg_in(kp, I_BRE) + ((size_t)g * 64 + n) * 16); const f32x4* bi = (const f32x4*)(karg_in(kp, I_BIM) + ((size_t)g * 64 + n) * 16);
#pragma unroll
          for (int q = 0; q < 4; ++q) { const f32x4 vr = br[q], vi = bi[q];
#pragma unroll
              for (int j = 0; j < 4; ++j) bb2[4 * q + j] = (f32x2){cr * vr[j] - ci * vi[j], cr * vi[j] + ci * vr[j]}; } }
        float xr = 0.f, xi = 0.f;
        bf16x8 cfr[4]; float dsk = 0.f;
        if (PASS2) {
            const f32x2 c0 = ((const f32x2*)(karg_ws(kp) + WS_S5C))[((size_t)g * 64 + seg) * 64 + n]; xr = c0[0]; xi = c0[1];
            const int p = lane & 15, kq = lane >> 4;
#pragma unroll
            for (int s = 0; s < 4; ++s) { const float* src = ((s < 2) ? karg_in(kp, I_CRE) : karg_in(kp, I_CIM)) + ((size_t)g * 16 + p) * 64 + 32 * (s & 1) + 8 * kq; const float sg = (s < 2) ? 1.0f : -1.0f;
                const f32x4 v0 = *(const f32x4*)src * sg, v1 = *(const f32x4*)(src + 4) * sg;
                u32x4 w; w.x = cvtpk(v0[0], v0[1]); w.y = cvtpk(v0[2], v0[3]); w.z = cvtpk(v1[0], v1[1]); w.w = cvtpk(v1[2], v1[3]); cfr[s] = __builtin_bit_cast(bf16x8, w); }
            dsk = karg_in(kp, I_S5D)[g * 16 + p];
        }
        const bf16_t* usrc = proj + (size_t)(t0 + (lane >> 2)) * OD_IN + 1536 + g * 16 + 4 * (lane & 3);
        u32x2 un = *(const u32x2*)usrc;
        for (int blk = 0; blk < 16; ++blk) {
            *(LAS f32x4*)(ubuf + (lane >> 2) * 16 + 4 * (lane & 3)) = (f32x4){bf_lo(un.x), bf_hi(un.x), bf_lo(un.y), bf_hi(un.y)};
            if (blk < 15) un = *(const u32x2*)(usrc + (size_t)(blk + 1) * 16 * OD_IN);
            LDSW();
#pragma unroll 4
            for (int tt = 0; tt < 16; ++tt) {
                const f32x4 u0 = *(const LAS f32x4*)(ubuf + tt * 16), u1 = *(const LAS f32x4*)(ubuf + tt * 16 + 4), u2 = *(const LAS f32x4*)(ubuf + tt * 16 + 8), u3 = *(const LAS f32x4*)(ubuf + tt * 16 + 12);
                f32x2 bua = bb2[0] * u0[0], bub = bb2[1] * u0[1];
                bua = __builtin_elementwise_fma(bb2[2], (f32x2){u0[2], u0[2]}, bua); bub = __builtin_elementwise_fma(bb2[3], (f32x2){u0[3], u0[3]}, bub);
#pragma unroll
                for (int j = 0; j < 4; j += 2) { bua = __builtin_elementwise_fma(bb2[4 + j], (f32x2){u1[j], u1[j]}, bua); bub = __builtin_elementwise_fma(bb2[5 + j], (f32x2){u1[j + 1], u1[j + 1]}, bub); }
#pragma unroll
                for (int j = 0; j < 4; j += 2) { bua = __builtin_elementwise_fma(bb2[8 + j], (f32x2){u2[j], u2[j]}, bua); bub = __builtin_elementwise_fma(bb2[9 + j], (f32x2){u2[j + 1], u2[j + 1]}, bub); }
#pragma unroll
                for (int j = 0; j < 4; j += 2) { bua = __builtin_elementwise_fma(bb2[12 + j], (f32x2){u3[j], u3[j]}, bua); bub = __builtin_elementwise_fma(bb2[13 + j], (f32x2){u3[j + 1], u3[j + 1]}, bub); }
                const f32x2 bu = bua + bub;
                const f32x2 xs = __builtin_elementwise_fma((f32x2){-ai, ai}, (f32x2){xi, xr}, bu);
                const f32x2 xn = __builtin_elementwise_fma((f32x2){ar, ar}, (f32x2){xr, xi}, xs);
                xr = xn[0]; xi = xn[1];
                if (PASS2) { xt[tt * 136 + n] = (bf16_t)(cvtpk(xr, 0.f) & 0xffffu); xt[tt * 136 + 64 + n] = (bf16_t)(cvtpk(xi, 0.f) & 0xffffu); }
            }
            if (PASS2) {
                LDSW();
                f32x4 y = (f32x4){0.f, 0.f, 0.f, 0.f};
#pragma unroll
                for (int s = 0; s < 4; ++s) y = MFMA16(*(const LAS bf16x8*)(xt + (lane & 15) * 136 + 32 * s + 8 * (lane >> 4)), cfr[s], y);
                const int p = lane & 15;
#pragma unroll
                for (int i = 0; i < 4; ++i) { const int t = 4 * (lane >> 4) + i; const float v = y[i] + dsk * ubuf[t * 16 + p];
                    yg[(size_t)(t0 + blk * 16 + t) * 512 + g * 16 + p] = (bf16_t)(cvtpk(gelu_t(v), 0.f) & 0xffffu); }
            }
            LDSW();
        }
        if (!PASS2) ((f32x2*)(karg_ws(kp) + WS_S5L))[((size_t)g * 64 + seg) * 64 + n] = (f32x2){xr, xi};
    }
}
__device__ __forceinline__ void phase_scans(kptr_t kp0, int vcu, int G) { const kptr_t kp = klaunder(kp0);
    const int gid = vcu * 512 + tid_opaque(), GN = G * 512;
    for (int idx = gid; idx < 32768 + 2048; idx += GN) {
        if (idx < 32768) {
            const int h = idx >> 13, de = idx & 8191; const float cd4 = __builtin_amdgcn_exp2f(ret_lg2(h) * 256.0f);
            const float* src = (const float*)(karg_ws(kp) + WS_RETL) + (size_t)h * 8192 + de; float* dst = (float*)(karg_ws(kp) + WS_RETC) + (size_t)h * 8192 + de;
            float C = 0.f;
            for (int g0 = 0; g0 < 64; g0 += 8) { float e[8];
#pragma unroll
                for (int k = 0; k < 8; ++k) e[k] = src[(size_t)(g0 + k) * 32768];
#pragma unroll
                for (int k = 0; k < 8; ++k) { dst[(size_t)(g0 + k) * 32768] = C; C = cd4 * C + e[k]; } }
        } else {
            const int i2 = idx - 32768, g = i2 >> 6, n = i2 & 63;
            const f32x2 A256 = ((const f32x2*)(karg_ws(kp) + WS_S5A))[i2]; const float Ar = A256[0], Ai = A256[1];
            const f32x2* src = (const f32x2*)(karg_ws(kp) + WS_S5L) + (size_t)g * 4096 + n; f32x2* dst = (f32x2*)(karg_ws(kp) + WS_S5C) + (size_t)g * 4096 + n;
            float cr = 0.f, ci = 0.f;
            for (int s0 = 0; s0 < 64; s0 += 8) { f32x2 e[8];
#pragma unroll
                for (int k = 0; k < 8; ++k) e[k] = src[(s0 + k) * 64];
#pragma unroll
                for (int k = 0; k < 8; ++k) { dst[(s0 + k) * 64] = (f32x2){cr, ci}; const float nr = Ar * cr - Ai * ci + e[k][0], ni = Ar * ci + Ai * cr + e[k][1]; cr = nr; ci = ni; } }
        }
    }
}
__device__ __forceinline__ void ffn_fixup(kptr_t kp0, int layer, int pm) { const kptr_t kp = klaunder(kp0);
    if (pm > 0) {
        const float* hv = (const float*)(karg_ws(kp) + WS_HEADV) + (size_t)pm * 2 * 2816; const float* hg = (const float*)(karg_ws(kp) + WS_HEADG) + (size_t)pm * 2 * 2816;
        const float* tg = (const float*)(karg_ws(kp) + WS_TAILG) + (size_t)(pm - 1) * 2 * 2816;
        const float* cw = karg_in(kp, I_CONVW) + (size_t)layer * 3 * 2816; const float* cb = karg_in(kp, I_CONVB) + (size_t)layer * 2816;
        bf16_t* act = (bf16_t*)(karg_ws(kp) + WS_PROJ) + (size_t)pm * 256 * 2816;
        for (int f = tid_opaque(); f < 2816; f += 512) {
            const float gm2 = tg[f], gm1 = tg[2816 + f], g0 = hg[f], g1 = hg[2816 + f], w0 = cw[f], w1 = cw[2816 + f], w2 = cw[5632 + f], b = cb[f];
            act[f] = (bf16_t)(cvtpk(gelu_t(w0 * gm2 + w1 * gm1 + w2 * g0 + b) * hv[f], 0.f) & 0xffffu);
            act[2816 + f] = (bf16_t)(cvtpk(gelu_t(w0 * gm1 + w1 * g0 + w2 * g1 + b) * hv[2816 + f], 0.f) & 0xffffu);
        }
    }
    asm volatile("s_waitcnt vmcnt(0)" ::: "memory");
    __builtin_amdgcn_fence(__ATOMIC_RELEASE, "agent");
    __builtin_amdgcn_fence(__ATOMIC_ACQUIRE, "agent");
    asm volatile("s_waitcnt vmcnt(0)" ::: "memory");
    __syncthreads();
}
__device__ __forceinline__ void phase_final(kptr_t kp0, int vcu, int G) { const kptr_t kp = klaunder(kp0);
    const int tid_ = tid_opaque(), lane = tid_ & 63, wid = tid_ >> 6, gw = vcu * NW + wid, NGW = G * NW;
    const float* rowss = (const float*)(karg_ws(kp) + WS_ROWSS) + (size_t)4 * L * 16;
    f32x4 gv[4];
#pragma unroll
    for (int j = 0; j < 4; ++j) gv[j] = *(const f32x4*)(karg_in(kp, I_FING) + 4 * lane + 256 * j);
    for (int m = gw; m < L; m += NGW) {
        const float rs = 1.0f / sqrtf(wave_sum(lane < 16 ? rowss[(size_t)m * 16 + lane] : 0.f) * (1.0f / 1024.0f) + EPS);
        f32x4* xr = (f32x4*)(karg_out(kp) + (size_t)m * 1024) + lane;
#pragma unroll
        for (int j = 0; j < 4; ++j) xr[64 * j] = xr[64 * j] * rs * gv[j];
    }
}
#ifdef NO_G_PROJ
#define EN_PROJ 0
#else
#define EN_PROJ 1
#endif
#ifdef NO_G_RES1
#define EN_RES1 0
#else
#define EN_RES1 1
#endif
#ifdef NO_G_ROPE
#define EN_ROPE 0
#else
#define EN_ROPE 1
#endif
#ifdef NO_G_GLU
#define EN_GLU 0
#else
#define EN_GLU 1
#endif
#ifdef NO_G_RES2
#define EN_RES2 0
#else
#define EN_RES2 1
#endif
#ifdef NO_G_FFN
#define EN_FFN 0
#else
#define EN_FFN 1
#endif
#ifdef NO_G_RES3
#define EN_RES3 0
#else
#define EN_RES3 1
#endif
#ifdef NO_GSYNC
#define GSYNC() __syncthreads()
#else
#define GSYNC() xcd_barrier(xbar)
#endif
#define XB_TMO      128
#define XB_XCNT(j)  (256  + 64 * (j))
#define XB_XSUB(j)  (1280 + 64 * (j))
#define XB_XGEN(j)  (2304 + 64 * (j))
#define XB_TOP      3328
#define XB_TOPGEN   3392
#define XCD_BAR_WORDS 3456
#define XB_SPIN_CAP (1u << 18)

__device__ __forceinline__ unsigned xb_ld(unsigned* p)              { return __hip_atomic_load(p, __ATOMIC_RELAXED, __HIP_MEMORY_SCOPE_AGENT); }
__device__ __forceinline__ unsigned xb_add(unsigned* p, unsigned v) { return __hip_atomic_fetch_add(p, v, __ATOMIC_RELAXED, __HIP_MEMORY_SCOPE_AGENT); }
__device__ __forceinline__ unsigned xb_xcc_id() { return (unsigned)__builtin_amdgcn_s_getreg((3 << 11) | 20) & 0xFu; }
#define XB_SPIN(cond, bar) do { unsigned _sp = 0; while (cond) { __builtin_amdgcn_s_sleep(1); \
    if ((++_sp & 255u) == 0u) { if (xb_ld(&(bar)[XB_TMO])) break; if (_sp > XB_SPIN_CAP) { atomicAdd(&(bar)[XB_TMO], 1u); break; } } } } while (0)

struct XcdBarrier {
    unsigned* bar; unsigned x;
    volatile LAS unsigned* st;
};

__device__ __forceinline__ XcdBarrier xcd_barrier_post(unsigned* bar, volatile LAS unsigned* st) {
    XcdBarrier b; b.bar = bar; b.x = xb_xcc_id(); b.st = st;
    if (threadIdx.x == 0) (void)xb_add(&bar[XB_XCNT(b.x)], 1u);
    return b;
}
__device__ __forceinline__ void xcd_barrier_complete(unsigned* bar, unsigned x, unsigned& nloc, unsigned& nx) {
    const unsigned G = gridDim.x * gridDim.y * gridDim.z;
    unsigned sum, cnt, mine, sp = 0u;
    for (;;) {
        sum = 0u; cnt = 0u; mine = 0u;
#pragma unroll
        for (unsigned j = 0; j < 16; ++j) { const unsigned c = xb_ld(&bar[XB_XCNT(j)]); sum += c; cnt += (c > 0u) ? 1u : 0u; mine = (j == x) ? c : mine; }
        if (sum == G) break;
        __builtin_amdgcn_s_sleep(1);
        if ((++sp & 255u) == 0u) { if (xb_ld(&bar[XB_TMO])) break; if (sp > XB_SPIN_CAP) { atomicAdd(&bar[XB_TMO], 1u); break; } }
    }
    nloc = mine > 0u ? mine : 1u; nx = cnt > 0u ? cnt : 1u;
}

__device__ __forceinline__ void xcd_barrier(const XcdBarrier& b) {
    asm volatile("s_waitcnt vmcnt(0)" ::: "memory");
    __syncthreads();
    if (threadIdx.x == 0) {
        unsigned* bar = b.bar;
        __builtin_amdgcn_s_waitcnt(0);
        unsigned nloc = b.st[0], nx = b.st[1];
        if (nloc == 0u) { xcd_barrier_complete(bar, b.x, nloc, nx); b.st[0] = nloc; b.st[1] = nx; }
        const unsigned old = xb_add(&bar[XB_XSUB(b.x)], 1u);
        const unsigned gen = old / nloc;
        if (old + 1u == (gen + 1u) * nloc) {
            __builtin_amdgcn_fence(__ATOMIC_RELEASE, "agent");
            asm volatile("s_waitcnt vmcnt(0)" ::: "memory");
            const unsigned og = xb_add(&bar[XB_TOP], 1u);
            const unsigned tg = og / nx;
            if (og + 1u == (tg + 1u) * nx) xb_add(&bar[XB_TOPGEN], 1u);
            else XB_SPIN(xb_ld(&bar[XB_TOPGEN]) == tg, bar);
            __builtin_amdgcn_fence(__ATOMIC_ACQUIRE, "agent");
            xb_add(&bar[XB_XGEN(b.x)], 1u);
            asm volatile("s_waitcnt vmcnt(0)" ::: "memory");
        } else {
            XB_SPIN(xb_ld(&bar[XB_XGEN(b.x)]) == gen, bar);
            __builtin_amdgcn_fence(__ATOMIC_ACQUIRE, "agent");
            asm volatile("s_waitcnt vmcnt(0)" ::: "memory");
        }
    }
    __syncthreads();
}


#ifndef STOP_AFTER
#define STOP_AFTER 0
#endif
__global__ void __launch_bounds__(512, 2) mega_fwd(Args a_unused) {
#define kp (kargs_fresh())
    extern __shared__ __attribute__((aligned(16))) unsigned char lds_raw[];
    LAS unsigned char* lds = (LAS unsigned char*)lds_raw;
    if (threadIdx.x < 64) ((LAS unsigned*)(lds + LDS_CTL))[threadIdx.x] = 0u;
    __syncthreads();
    XcdBarrier xbar = xcd_barrier_post((unsigned*)(karg_ws(kargs_fresh()) + WS_CTL), (volatile LAS unsigned*)(lds + LDS_CTL));
    const int G = gridDim.x, bx = blockIdx.x, vcu = (G % 8 == 0) ? (bx % 8) * (G / 8) + bx / 8 : bx;
#define ws (karg_ws(kargs_fresh()))
#define mod ((const float*)(ws + WS_MOD))
#define gmv ((const float*)(ws + WS_GM))
#define bvec ((const float*)(ws + WS_BV))
#define rowss ((float*)(ws + WS_ROWSS))
#define AP ((bf16_t*)(ws + WS_AP))
#define PROJ ((bf16_t*)(ws + WS_PROJ))
#define CAT ((bf16_t*)(ws + WS_CAT))
#ifdef NO_GEMM
#define GEMM_PHASE(EPI, Aptr, Bptr, N_, K_, E_) do {} while (0)
#else
#define GEMM_PHASE(EPI, Aptr, Bptr, N_, K_, E_) do { int gG_ = G, gbx_ = bx; asm volatile("" : "+s"(gG_), "+s"(gbx_));     \
        pg8::Gemm g_{(const pg8::bf16_t*)(Aptr), (const pg8::bf16_t*)(Bptr), L, (N_), (K_)}; pg8::StaticOrder S_; S_.init(L, (N_), gG_, gbx_); \
        pg8::gemm_phase<EPI, pg8::StaticOrder, true, true>(lds, g_, S_, E_); } while (0)
#endif

#ifndef NO_P0
    phase_p0a(kargs_fresh(), lds, vcu, G); GSYNC();
    phase_p0b(kargs_fresh(), vcu, G); GSYNC();
    phase_p0c(kargs_fresh(), vcu, G); GSYNC();
#endif
#ifdef DUMP_WS_BF16
    { const int gid_ = vcu * 512 + tid_opaque(); for (size_t i = gid_; i < (size_t)L * 1024; i += (size_t)G * 512) karg_out(kp)[i] = bf1(((const bf16_t*)(ws + (size_t)(DUMP_WS_BF16)))[i % (size_t)(DUMP_N)]); return; }
#endif
#ifdef DUMP_WS_F32
    { const int gid_ = vcu * 512 + tid_opaque(); for (size_t i = gid_; i < (size_t)L * 1024; i += (size_t)G * 512) karg_out(kp)[i] = ((const float*)(ws + (size_t)(DUMP_WS_F32)))[i % (size_t)(DUMP_N)]; return; }
#endif
#define modl (mod + layer * 6144)
    {
        constexpr int layer = 0;
            { pg8::EpiProj E{PROJ, EV_IN, bvec, rowss, 0xC3u}; if (EN_PROJ) GEMM_PHASE(pg8::EpiProj, AP, ws + WS_WEVIN, EV_IN, 1024, E); }
            GSYNC();
#ifdef TIME_DUP_GEMMS
            { pg8::EpiProj E{PROJ, EV_IN, bvec, rowss, 0xC3u}; GEMM_PHASE(pg8::EpiProj, AP, ws + WS_WEVIN, EV_IN, 1024, E); }
            GSYNC();
#endif
#ifndef NO_ATTN
            phase_attn(kargs_fresh(), lds, vcu, G);
#ifdef TIME_DUP_ATTN
            GSYNC(); phase_attn(kargs_fresh(), lds, vcu, G);
#endif
#endif
            GSYNC();
#ifdef DUMP_CAT
            { const int gid_ = vcu * 512 + tid_opaque(); for (size_t i = gid_; i < (size_t)L * 1024; i += (size_t)G * 512) karg_out(kp)[i] = bf1(CAT[i]); return; }
#endif
#ifdef DUMP_PROJ
            { const int gid_ = vcu * 512 + tid_opaque(); for (size_t i = gid_; i < (size_t)L * 1024; i += (size_t)G * 512) { const size_t r = i >> 10, c = i & 1023; karg_out(kp)[i] = bf1(PROJ[r * 3072 + (DUMP_PROJ) * 1024 + c]); } return; }
#endif
            { pg8::EpiRes E{karg_in(kp, I_X), karg_out(kp), modl + 2048, gmv + 1024, AP, rowss + (size_t)L * 16}; if (EN_RES1) GEMM_PHASE(pg8::EpiRes, CAT, ws + WS_WEVOUT, 1024, 1024, E); }
            GSYNC();
#ifdef DUP_EVOUT_1
            { pg8::EpiRes E{karg_in(kp, I_X), karg_out(kp), mod + 2048, gmv + 1024, AP, rowss + (size_t)L * 16}; GEMM_PHASE(pg8::EpiRes, CAT, ws + WS_WEVOUT, 1024, 1024, E); }
            GSYNC();
#endif
#if STOP_AFTER == 1
            return;
#endif
        { pg8::EpiFfn E{PROJ, bvec + 5120 + layer * 5632, rowss + (size_t)(layer ? 3 : 1) * L * 16, karg_in(kp, I_CONVW) + (size_t)layer * 3 * 2816, karg_in(kp, I_CONVB) + (size_t)layer * 2816,
                        (float*)(ws + WS_HEADV), (float*)(ws + WS_HEADG), (float*)(ws + WS_TAILG), (LAS float*)(lds + LDS_XG)};
          if (EN_FFN) GEMM_PHASE(pg8::EpiFfn, AP, ws + WS_WFFIN + layer * WFFIN_STRIDE, 5632, 1024, E); }
        GSYNC();
#ifdef TIME_DUP_GEMMS
        if (layer == 0) { pg8::EpiFfn E{PROJ, bvec + 5120 + layer * 5632, rowss + (size_t)(layer ? 3 : 1) * L * 16, karg_in(kp, I_CONVW) + (size_t)layer * 3 * 2816, karg_in(kp, I_CONVB) + (size_t)layer * 2816,
                        (float*)(ws + WS_HEADV), (float*)(ws + WS_HEADG), (float*)(ws + WS_TAILG), (LAS float*)(lds + LDS_XG)};
          GEMM_PHASE(pg8::EpiFfn, AP, ws + WS_WFFIN + layer * WFFIN_STRIDE, 5632, 1024, E); GSYNC(); }
#endif
#ifdef DUP_EVOUT_FFNIN
        { pg8::EpiRes E{karg_in(kp, I_X), karg_out(kp), mod + 2048, gmv + 1024, AP, rowss + (size_t)L * 16}; GEMM_PHASE(pg8::EpiRes, CAT, ws + WS_WEVOUT, 1024, 1024, E); }
        GSYNC();
        return;
#endif
        { pg8::StaticOrder S0; S0.init(L, 1024, G, bx); pg8::Unit u0; for (int i = 0; S0.next(i, u0); ++i) ffn_fixup(kargs_fresh(), layer, u0.pm);
          pg8::EpiRes E{karg_out(kp), karg_out(kp), modl + 5120, layer ? nullptr : gmv + 2048, AP, rowss + (size_t)(layer ? 4 : 2) * L * 16}; if (EN_RES3) GEMM_PHASE(pg8::EpiRes, PROJ, ws + WS_WFFOUT + layer * WFFOUT_STRIDE, 1024, 2816, E); }
        GSYNC();
#if STOP_AFTER == 2
        if (layer == 0) {
#ifdef PRE_SYNCS
            for (int q = 0; q < PRE_SYNCS; ++q) GSYNC();
#endif
#ifdef DUP_AFTER_FFNOUT
            { pg8::EpiRes E{karg_in(kp, I_X), karg_out(kp), mod + 2048, gmv + 1024, AP, rowss + (size_t)L * 16}; GEMM_PHASE(pg8::EpiRes, CAT, ws + WS_WEVOUT, 1024, 1024, E); }
            GSYNC();
#endif
#ifdef EXTRA_SYNCS
            for (int q = 0; q < EXTRA_SYNCS; ++q) GSYNC();
#endif
#ifdef END_DUMP_BF16
            { const int gid_ = vcu * 512 + tid_opaque(); for (size_t i = gid_; i < (size_t)L * 1024; i += (size_t)G * 512) karg_out(kp)[i] = bf1(((const bf16_t*)(ws + (size_t)(END_DUMP_BF16)))[i % (size_t)(DUMP_N)]); }
#endif
#ifdef END_DUMP_F32
            { const int gid_ = vcu * 512 + tid_opaque(); for (size_t i = gid_; i < (size_t)L * 1024; i += (size_t)G * 512) karg_out(kp)[i] = ((const float*)(ws + (size_t)(END_DUMP_F32)))[i % (size_t)(DUMP_N)]; }
#endif
            return; }
#endif
    }
    {
        constexpr int layer = 1;
            { pg8::EpiRope E{PROJ, OD_IN, bvec + 3072, rowss + (size_t)2 * L * 16, (const float*)(ws + WS_ROPE)}; if (EN_ROPE) GEMM_PHASE(pg8::EpiRope, AP, ws + WS_WODIN, OD_IN, 1024, E); }
            GSYNC();
#if !defined(NO_RET) && !defined(NO_RET1)
            phase_ret1(kargs_fresh(), lds, vcu, G);
#endif
#ifndef NO_S5
            phase_s5<false>(kargs_fresh(), lds, vcu, G);
#endif
            GSYNC();
#ifndef NO_SCAN
            phase_scans(kargs_fresh(), vcu, G);
#endif
            GSYNC();
#if !defined(NO_RET) && !defined(NO_RET2)
            phase_ret2(kargs_fresh(), lds, vcu, G);
#endif
#ifndef NO_S5
            phase_s5<true>(kargs_fresh(), lds, vcu, G);
#endif
#ifdef TIME_DUP_ODD
            GSYNC(); phase_ret1(kargs_fresh(), lds, vcu, G); phase_s5<false>(kargs_fresh(), lds, vcu, G); GSYNC(); phase_scans(kargs_fresh(), vcu, G); GSYNC(); phase_ret2(kargs_fresh(), lds, vcu, G); phase_s5<true>(kargs_fresh(), lds, vcu, G);
#endif
#ifdef TIME_EXTRA_SYNCS
            for (int q_ = 0; q_ < TIME_EXTRA_SYNCS; ++q_) GSYNC();
#endif
            GSYNC();
            { pg8::EpiGlu E{CAT, 1024, 512}; if (EN_GLU) GEMM_PHASE(pg8::EpiGlu, ws + WS_YG, ws + WS_WGLU, 1024, 512, E); }
            GSYNC();
            { pg8::EpiRes E{karg_out(kp), karg_out(kp), modl + 2048, gmv + 3072, AP, rowss + (size_t)3 * L * 16}; if (EN_RES2) GEMM_PHASE(pg8::EpiRes, CAT, ws + WS_WODOUT, 1024, 1024, E); }
            GSYNC();
#if STOP_AFTER == 3
            return;
#endif
        { pg8::EpiFfn E{PROJ, bvec + 5120 + layer * 5632, rowss + (size_t)(layer ? 3 : 1) * L * 16, karg_in(kp, I_CONVW) + (size_t)layer * 3 * 2816, karg_in(kp, I_CONVB) + (size_t)layer * 2816,
                        (float*)(ws + WS_HEADV), (float*)(ws + WS_HEADG), (float*)(ws + WS_TAILG), (LAS float*)(lds + LDS_XG)};
          if (EN_FFN) GEMM_PHASE(pg8::EpiFfn, AP, ws + WS_WFFIN + layer * WFFIN_STRIDE, 5632, 1024, E); }
        GSYNC();
#ifdef TIME_DUP_GEMMS
        if (layer == 0) { pg8::EpiFfn E{PROJ, bvec + 5120 + layer * 5632, rowss + (size_t)(layer ? 3 : 1) * L * 16, karg_in(kp, I_CONVW) + (size_t)layer * 3 * 2816, karg_in(kp, I_CONVB) + (size_t)layer * 2816,
                        (float*)(ws + WS_HEADV), (float*)(ws + WS_HEADG), (float*)(ws + WS_TAILG), (LAS float*)(lds + LDS_XG)};
          GEMM_PHASE(pg8::EpiFfn, AP, ws + WS_WFFIN + layer * WFFIN_STRIDE, 5632, 1024, E); GSYNC(); }
#endif
#ifdef DUP_EVOUT_FFNIN
        { pg8::EpiRes E{karg_in(kp, I_X), karg_out(kp), mod + 2048, gmv + 1024, AP, rowss + (size_t)L * 16}; GEMM_PHASE(pg8::EpiRes, CAT, ws + WS_WEVOUT, 1024, 1024, E); }
        GSYNC();
        return;
#endif
        { pg8::StaticOrder S0; S0.init(L, 1024, G, bx); pg8::Unit u0; for (int i = 0; S0.next(i, u0); ++i) ffn_fixup(kargs_fresh(), layer, u0.pm);
          pg8::EpiRes E{karg_out(kp), karg_out(kp), modl + 5120, layer ? nullptr : gmv + 2048, AP, rowss + (size_t)(layer ? 4 : 2) * L * 16}; if (EN_RES3) GEMM_PHASE(pg8::EpiRes, PROJ, ws + WS_WFFOUT + layer * WFFOUT_STRIDE, 1024, 2816, E); }
        GSYNC();
#if STOP_AFTER == 2
        if (layer == 0) {
#ifdef PRE_SYNCS
            for (int q = 0; q < PRE_SYNCS; ++q) GSYNC();
#endif
#ifdef DUP_AFTER_FFNOUT
            { pg8::EpiRes E{karg_in(kp, I_X), karg_out(kp), mod + 2048, gmv + 1024, AP, rowss + (size_t)L * 16}; GEMM_PHASE(pg8::EpiRes, CAT, ws + WS_WEVOUT, 1024, 1024, E); }
            GSYNC();
#endif
#ifdef EXTRA_SYNCS
            for (int q = 0; q < EXTRA_SYNCS; ++q) GSYNC();
#endif
#ifdef END_DUMP_BF16
            { const int gid_ = vcu * 512 + tid_opaque(); for (size_t i = gid_; i < (size_t)L * 1024; i += (size_t)G * 512) karg_out(kp)[i] = bf1(((const bf16_t*)(ws + (size_t)(END_DUMP_BF16)))[i % (size_t)(DUMP_N)]); }
#endif
#ifdef END_DUMP_F32
            { const int gid_ = vcu * 512 + tid_opaque(); for (size_t i = gid_; i < (size_t)L * 1024; i += (size_t)G * 512) karg_out(kp)[i] = ((const float*)(ws + (size_t)(END_DUMP_F32)))[i % (size_t)(DUMP_N)]; }
#endif
            return; }
#endif
    }
    phase_final(kargs_fresh(), vcu, G);
#undef ws
#undef mod
#undef gmv
#undef bvec
#undef rowss
#undef AP
#undef PROJ
#undef CAT
#undef modl
#undef kp
}
extern "C" void kernel_launch(void* const* d_in, const int* in_sizes, int n_in, void* d_out, int out_size, void* d_ws, size_t ws_size, hipStream_t stream) {
    static int grid = 0;
    if (grid == 0) {
        if (n_in != 28 || out_size != L * DM || ws_size < WS_END) { fprintf(stderr, "kernel_launch: unexpected problem (n_in %d out %d ws %zu)\n", n_in, out_size, ws_size); grid = -1; return; }
        int dev = 0, cus = 0, per_cu = 0;
        hipGetDevice(&dev); hipDeviceGetAttribute(&cus, hipDeviceAttributeMultiprocessorCount, dev);
        hipFuncSetAttribute((const void*)mega_fwd, hipFuncAttributeMaxDynamicSharedMemorySize, LDS_BYTES);
        hipOccupancyMaxActiveBlocksPerMultiprocessor(&per_cu, (const void*)mega_fwd, 512, LDS_BYTES);
        (void)hipGetLastError();
        if (per_cu < 1) { fprintf(stderr, "kernel_launch: occupancy query says %d blocks per CU\n", per_cu); per_cu = 1; }
        grid = cus;
    }
    if (grid < 0) return;
    Args a{};
    for (int i = 0; i < 28; ++i) a.in[i] = (const float*)d_in[i];
    a.out = (float*)d_out; a.ws = (unsigned char*)d_ws;
    if (hipMemsetAsync((char*)d_ws + WS_CTL, 0, CTL_BYTES, stream) != hipSuccess) { fprintf(stderr, "kernel_launch: hipMemsetAsync failed\n"); return; }
    void* args[] = {&a};
    hipError_t e = hipLaunchCooperativeKernel((void*)mega_fwd, dim3(grid), dim3(512), args, LDS_BYTES, stream);
    if (e != hipSuccess) fprintf(stderr, "cooperative launch failed: %s (grid %d)\n", hipGetErrorString(e), grid);
}
```
